# Optimizing an MI355X kernel written in HIP

```python
import math
import jax, jax.numpy as jnp
from jax import lax
import numpy as np

D_MODEL = 1024
BATCH = 2
SEQ = 8192
DEPTH = 4

N_MEM = 256
HEAD_DIM = 64
ROPE_THETA = 500000.0
ROPE_DIM = HEAD_DIM // 4
NORM_EPS = 1e-6
NEG_INF = -1e30
ATTN_Q_BLOCK = 128

A_HEADS = 6
MOBA_BLOCK = 256
MOBA_TOPK = 3
MOBA_Q_BLOCK = 64
B_HEADS = 6
B_LORA_W = 32
B_LORA_A = 32
RWKV_GN_EPS = 64e-5
C_HEADS = 4
C_VDIM = 2 * HEAD_DIM
D_HEADS = 4
D_CHUNK = 64
M_HEADS = 4

A_W = A_HEADS * HEAD_DIM
B_W = B_HEADS * HEAD_DIM
C_W = C_HEADS * C_VDIM
D_W = D_HEADS * HEAD_DIM
M_W = M_HEADS * HEAD_DIM
MIX_W_EVEN = A_W + B_W + M_W
MIX_W_ODD = C_W + D_W + M_W
B_SHIFT_W = 3 * B_W + B_LORA_W + B_LORA_A
EVEN_SIZES = (A_W, A_W, A_W, A_W, B_SHIFT_W, B_W, M_W, M_W)
ODD_SIZES = (2 * C_HEADS * HEAD_DIM, 2 * C_HEADS * HEAD_DIM, C_W, C_W, D_W, D_W, D_W, D_W, M_W, M_W)
EVEN_IN = sum(EVEN_SIZES)
ODD_IN = sum(ODD_SIZES)
N_EVEN = (DEPTH + 1) // 2
N_ODD = DEPTH // 2

kernel_name = 'hybrid_moba_rwkv7_diffattn_hgrn2'

F32 = jnp.float32


def rms_norm(x, g, eps=NORM_EPS):
    xf = x.astype(F32)
    y = xf * lax.rsqrt(jnp.mean(xf * xf, axis=-1, keepdims=True) + eps)
    return (y * g.astype(F32)).astype(x.dtype)


def split_last(t, sizes):
    return jnp.split(t, np.cumsum(sizes)[:-1].tolist(), axis=-1)


def split_heads(t, n):
    b, s, w = t.shape
    return t.reshape(b, s, n, w // n).transpose(0, 2, 1, 3)


def merge_heads(t):
    b, h, s, d = t.shape
    return t.transpose(0, 2, 1, 3).reshape(b, s, h * d)


def rope_tables(seq):
    pos = jnp.arange(seq, dtype=F32)
    inv = 1.0 / (ROPE_THETA ** (jnp.arange(0, ROPE_DIM, 2, dtype=F32) / ROPE_DIM))
    ang = pos[:, None] * inv[None, :]
    return jnp.cos(ang), jnp.sin(ang)


def partial_rope(x, cos, sin):
    xr = x[..., :ROPE_DIM].astype(F32)
    x1, x2 = xr[..., :ROPE_DIM // 2], xr[..., ROPE_DIM // 2:]
    rot = jnp.concatenate([x1 * cos - x2 * sin, x1 * sin + x2 * cos], axis=-1).astype(x.dtype)
    return jnp.concatenate([rot, x[..., ROPE_DIM:]], axis=-1)


def token_shift(t, mu):
    prev = jnp.pad(t, ((0, 0), (1, 0), (0, 0)))[:, :-1]
    return t + (prev - t) * mu


def moba_attention(q, k, v):
    bn, h, s, dh = q.shape
    nb = -(-s // MOBA_BLOCK)
    pad = nb * MOBA_BLOCK - s
    padw = ((0, 0), (0, 0), (0, pad), (0, 0))
    kp, vp = jnp.pad(k, padw), jnp.pad(v, padw)
    kb = kp.reshape(bn, h, nb, MOBA_BLOCK, dh)
    vb = vp.reshape(bn, h, nb, MOBA_BLOCK, dh)
    kmean = jnp.mean(kb.astype(F32), axis=3)
    topk = min(MOBA_TOPK, nb)
    scale = dh ** -0.5
    bidx = jnp.arange(bn)[:, None, None, None]
    hidx = jnp.arange(h)[None, :, None, None]
    blk_ids = jnp.arange(nb)
    own_off = jnp.arange(MOBA_BLOCK)

    def block(qi):
        q0 = qi * MOBA_Q_BLOCK
        qb = lax.dynamic_slice_in_dim(q, q0, MOBA_Q_BLOCK, axis=2)
        qpos = q0 + jnp.arange(MOBA_Q_BLOCK)
        own = q0 // MOBA_BLOCK
        gate = jnp.einsum('bhqd,bhnd->bhqn', qb.astype(F32), kmean)
        gate = jnp.where(blk_ids < own, gate, NEG_INF)
        _, sel = lax.top_k(gate, topk)
        valid = (sel < own)[..., None]
        ksel = kb[bidx, hidx, sel]
        vsel = vb[bidx, hidx, sel]
        s_sel = jnp.einsum('bhqd,bhqtld->bhqtl', qb, ksel).astype(F32) * scale
        s_sel = jnp.where(valid, s_sel, NEG_INF).reshape(bn, h, MOBA_Q_BLOCK, topk * MOBA_BLOCK)
        k_own = lax.dynamic_slice_in_dim(kp, own * MOBA_BLOCK, MOBA_BLOCK, axis=2)
        v_own = lax.dynamic_slice_in_dim(vp, own * MOBA_BLOCK, MOBA_BLOCK, axis=2)
        s_own = jnp.einsum('bhqd,bhld->bhql', qb, k_own).astype(F32) * scale
        s_own = jnp.where(own * MOBA_BLOCK + own_off[None, :] <= qpos[:, None], s_own, NEG_INF)
        p = jax.nn.softmax(jnp.concatenate([s_sel, s_own], axis=-1), axis=-1).astype(v.dtype)
        p_sel = p[..., :topk * MOBA_BLOCK].reshape(bn, h, MOBA_Q_BLOCK, topk, MOBA_BLOCK)
        p_own = p[..., topk * MOBA_BLOCK:]
        return (jnp.einsum('bhqtl,bhqtld->bhqd', p_sel, vsel)
                + jnp.einsum('bhql,bhld->bhqd', p_own, v_own))

    out = lax.map(block, jnp.arange(s // MOBA_Q_BLOCK))
    return jnp.moveaxis(out, 0, 2).reshape(bn, h, s, dh)


def rwkv7_scan(r, w, k, v, a, b):
    bn, s, h, dh = r.shape
    xs = tuple(jnp.moveaxis(t, 1, 0) for t in (r, w, k, v, a, b))

    def step(st, inp):
        r_t, w_t, k_t, v_t, a_t, b_t = inp
        sa = jnp.einsum('bhvk,bhk->bhv', st, a_t)
        st = st * w_t[:, :, None, :] + sa[..., None] * b_t[:, :, None, :] + v_t[..., None] * k_t[:, :, None, :]
        return st, jnp.einsum('bhvk,bhk->bhv', st, r_t)

    _, ys = lax.scan(step, jnp.zeros((bn, h, dh, dh), F32), xs)
    return jnp.moveaxis(ys, 0, 1)


def rwkv7_time_mix(bs, mu, w0, w2, a0, a2, k_k, k_a, r_k, lnx_g, lnx_b):
    bn, s, _ = bs.shape
    bs = token_shift(bs, mu)
    r, k, v, wl, al = (t.astype(F32) for t in split_last(bs, (B_W, B_W, B_W, B_LORA_W, B_LORA_A)))
    w_log = -jax.nn.softplus(-(w0.astype(F32) + jnp.tanh(wl) @ w2.astype(F32))) - 0.5
    decay = jnp.exp(-jnp.exp(w_log))
    a = jax.nn.sigmoid(a0.astype(F32) + al @ a2.astype(F32))
    kk = k * k_k.astype(F32)
    k = k * (1.0 + (a - 1.0) * k_a.astype(F32))
    hs = lambda t: t.reshape(bn, s, B_HEADS, HEAD_DIM)
    r, k, v, kk, a, decay = map(hs, (r, k, v, kk, a, decay))
    kk = kk * lax.rsqrt(jnp.maximum(jnp.sum(kk * kk, axis=-1, keepdims=True), 1e-24))
    y = rwkv7_scan(r, decay, k, v, -kk, kk * a)
    mean = jnp.mean(y, axis=-1, keepdims=True)
    var = jnp.mean(jnp.square(y - mean), axis=-1, keepdims=True)
    y = ((y - mean) * lax.rsqrt(var + RWKV_GN_EPS)).reshape(bn, s, B_W) * lnx_g.astype(F32) + lnx_b.astype(F32)
    bonus = jnp.sum(r * k * r_k.astype(F32), axis=-1, keepdims=True) * v
    return (y + bonus.reshape(bn, s, B_W)).astype(bs.dtype)


def diff_attention(q, k, v, lam):
    bn, h, _, s, dh = q.shape
    scale = dh ** -0.5
    kpos = jnp.arange(s)

    def block(qi):
        q0 = qi * ATTN_Q_BLOCK
        qb = lax.dynamic_slice_in_dim(q, q0, ATTN_Q_BLOCK, axis=3)
        qpos = q0 + jnp.arange(ATTN_Q_BLOCK)
        sc = jnp.einsum('bhmqd,bhmkd->bhmqk', qb, k).astype(F32) * scale
        sc = jnp.where(kpos[None, :] <= qpos[:, None], sc, NEG_INF)
        p = jax.nn.softmax(sc, axis=-1)
        pd = p[:, :, 0] - lam * p[:, :, 1]
        return jnp.einsum('bhqk,bhkd->bhqd', pd.astype(v.dtype), v)

    out = lax.map(block, jnp.arange(s // ATTN_Q_BLOCK))
    return jnp.moveaxis(out, 0, 2).reshape(bn, h, s, v.shape[-1])


def hgrn2_chunked(q, k, v, log_f):
    bn, h, s, dk = q.shape
    dv = v.shape[-1]
    nc = s // D_CHUNK
    chunks = lambda t: jnp.moveaxis(t.reshape(bn, h, nc, D_CHUNK, t.shape[-1]), 2, 0)
    causal = jnp.tril(jnp.ones((D_CHUNK, D_CHUNK), dtype=bool))[:, :, None]

    def step(st, inp):
        qt, kt, vt, gt = inp
        bcum = jnp.cumsum(gt, axis=2)
        inter = jnp.einsum('bhtd,bhde->bhte', qt * jnp.exp(bcum), st)
        diff = jnp.where(causal, bcum[:, :, :, None, :] - bcum[:, :, None, :, :], NEG_INF)
        scores = jnp.einsum('bhtd,bhsd,bhtsd->bhts', qt, kt, jnp.exp(diff))
        intra = jnp.einsum('bhts,bhse->bhte', scores, vt)
        b_last = bcum[:, :, -1:, :]
        st = st * jnp.exp(b_last[:, :, 0, :])[..., None] + jnp.einsum('bhsd,bhse->bhde', kt * jnp.exp(b_last - bcum), vt)
        return st, inter + intra

    _, o = lax.scan(step, jnp.zeros((bn, h, dk, dv), F32), tuple(map(chunks, (q, k, v, log_f))))
    return jnp.moveaxis(o, 0, 2).reshape(bn, h, s, dv)


def memory_kv(mem, g, w_kv, kn_g):
    km, vm = split_last(rms_norm(mem, g) @ w_kv, (M_W, M_W))
    return rms_norm(split_heads(km, M_HEADS), kn_g), split_heads(vm, M_HEADS)


def memory_attention(q, km, vm):
    sc = jnp.einsum('bhsd,bhmd->bhsm', q, km).astype(F32) * HEAD_DIM ** -0.5
    p = jax.nn.softmax(sc, axis=-1).astype(vm.dtype)
    return merge_heads(jnp.einsum('bhsm,bhmd->bhsd', p, vm))


def even_layer(h, km, vm, cos, sin, w_in, w_out, a_qn_g, a_kn_g, m_qn_g,
               b_mu, b_w0, b_w2, b_a0, b_a2, b_k_k, b_k_a, b_r_k, b_lnx_g, b_lnx_b):
    qa, ka, va, ga, bs, gb, qm, gm = split_last(h @ w_in, EVEN_SIZES)
    qa = partial_rope(rms_norm(split_heads(qa, A_HEADS), a_qn_g), cos, sin)
    ka = partial_rope(rms_norm(split_heads(ka, A_HEADS), a_kn_g), cos, sin)
    oa = merge_heads(moba_attention(qa, ka, split_heads(va, A_HEADS)))
    ob = rwkv7_time_mix(bs, b_mu, b_w0, b_w2, b_a0, b_a2, b_k_k, b_k_a, b_r_k, b_lnx_g, b_lnx_b)
    om = memory_attention(rms_norm(split_heads(qm, M_HEADS), m_qn_g), km, vm)
    mixed = jnp.concatenate([oa * jax.nn.silu(ga), ob * jax.nn.silu(gb), om * jax.nn.silu(gm)], axis=-1)
    return mixed @ w_out


def odd_layer(h, km, vm, cos, sin, li, lb, w_in, w_out, c_qn_g, c_kn_g,
              c_lq1, c_lk1, c_lq2, c_lk2, c_subln_g, d_gn_g, m_qn_g):
    bn, s, _ = h.shape
    qc, kc, vc, gc, qd, fd, idd, gd, qm, gm = split_last(h @ w_in, ODD_SIZES)
    pair_heads = lambda t: t.reshape(bn, s, C_HEADS, 2, HEAD_DIM).transpose(0, 2, 3, 1, 4)
    qc = partial_rope(rms_norm(pair_heads(qc), c_qn_g), cos, sin)
    kc = partial_rope(rms_norm(pair_heads(kc), c_kn_g), cos, sin)
    lam_init = 0.8 - 0.6 * math.exp(-0.3 * li)
    lam = (jnp.exp(jnp.sum(c_lq1.astype(F32) * c_lk1.astype(F32)))
           - jnp.exp(jnp.sum(c_lq2.astype(F32) * c_lk2.astype(F32))) + lam_init)
    oc = diff_attention(qc, kc, split_heads(vc, C_HEADS), lam)
    oc = merge_heads(rms_norm(oc, c_subln_g) * (1.0 - lam_init))
    fr = fd.astype(F32)
    log_f = jnp.logaddexp(jnp.log(lb), jnp.log1p(-lb) + jax.nn.log_sigmoid(fr))
    ig = (1.0 - lb) * jax.nn.sigmoid(-fr)
    od = hgrn2_chunked(split_heads(qd.astype(F32), D_HEADS), split_heads(ig, D_HEADS),
                       split_heads(idd.astype(F32), D_HEADS), split_heads(log_f, D_HEADS))
    od = merge_heads(rms_norm(od, d_gn_g)).astype(h.dtype)
    om = memory_attention(rms_norm(split_heads(qm, M_HEADS), m_qn_g), km, vm)
    mixed = jnp.concatenate([oc * jax.nn.silu(gc), od * jax.nn.silu(gd), om * jax.nn.silu(gm)], axis=-1)
    return mixed @ w_out


def setup_inputs(seed: int = 0) -> dict:
    key = jax.random.key(seed)
    ks = iter(jax.random.split(key, 40))
    nrm = lambda shape, scale: scale * jax.random.normal(next(ks), shape, F32)
    gain = lambda shape: 1.0 + 0.02 * jax.random.normal(next(ks), shape, F32)
    return {
        'x': nrm((BATCH, SEQ, D_MODEL), 1.0),
        'mem': nrm((BATCH, N_MEM, D_MODEL), 1.0),
        'ln_g': gain((DEPTH, D_MODEL)),
        'mem_ln_g': gain((DEPTH, D_MODEL)),
        'w_mem_kv': nrm((DEPTH, D_MODEL, 2 * M_W), D_MODEL ** -0.5),
        'm_qn_g': gain((DEPTH, HEAD_DIM)),
        'm_kn_g': gain((DEPTH, HEAD_DIM)),
        'e_w_in': nrm((N_EVEN, D_MODEL, EVEN_IN), D_MODEL ** -0.5),
        'e_w_out': nrm((N_EVEN, MIX_W_EVEN, D_MODEL), MIX_W_EVEN ** -0.5),
        'a_qn_g': gain((N_EVEN, HEAD_DIM)),
        'a_kn_g': gain((N_EVEN, HEAD_DIM)),
        'b_mu': jax.random.uniform(next(ks), (N_EVEN, B_SHIFT_W), F32),
        'b_w0': -2.0 + nrm((N_EVEN, B_W), 1.0),
        'b_w2': nrm((N_EVEN, B_LORA_W, B_W), 0.5 * B_LORA_W ** -0.5),
        'b_a0': nrm((N_EVEN, B_W), 0.1),
        'b_a2': nrm((N_EVEN, B_LORA_A, B_W), 0.5 * B_LORA_A ** -0.5),
        'b_k_k': 0.85 + nrm((N_EVEN, B_W), 0.05),
        'b_k_a': 1.0 + nrm((N_EVEN, B_W), 0.05),
        'b_r_k': nrm((N_EVEN, B_HEADS, HEAD_DIM), 0.1),
        'b_lnx_g': gain((N_EVEN, B_W)),
        'b_lnx_b': nrm((N_EVEN, B_W), 0.02),
        'o_w_in': nrm((N_ODD, D_MODEL, ODD_IN), D_MODEL ** -0.5),
        'o_w_out': nrm((N_ODD, MIX_W_ODD, D_MODEL), MIX_W_ODD ** -0.5),
        'c_qn_g': gain((N_ODD, HEAD_DIM)),
        'c_kn_g': gain((N_ODD, HEAD_DIM)),
        'c_lq1': nrm((N_ODD, HEAD_DIM), 0.1),
        'c_lk1': nrm((N_ODD, HEAD_DIM), 0.1),
        'c_lq2': nrm((N_ODD, HEAD_DIM), 0.1),
        'c_lk2': nrm((N_ODD, HEAD_DIM), 0.1),
        'c_subln_g': gain((N_ODD, C_VDIM)),
        'd_lb': nrm((N_ODD, D_W), 0.1),
        'd_gn_g': gain((N_ODD, HEAD_DIM)),
    }


def reference(x, mem, ln_g, mem_ln_g, w_mem_kv, m_qn_g, m_kn_g, e_w_in, e_w_out, a_qn_g, a_kn_g,
              b_mu, b_w0, b_w2, b_a0, b_a2, b_k_k, b_k_a, b_r_k, b_lnx_g, b_lnx_b,
              o_w_in, o_w_out, c_qn_g, c_kn_g, c_lq1, c_lk1, c_lq2, c_lk2, c_subln_g, d_lb, d_gn_g):
    cos, sin = rope_tables(x.shape[1])
    lbs = jax.nn.softmax(d_lb.astype(F32), axis=0)
    lbs = jnp.cumsum(lbs, axis=0) - lbs[0:1]
    for li in range(DEPTH):
        j = li // 2
        h = rms_norm(x, ln_g[li])
        km, vm = memory_kv(mem, mem_ln_g[li], w_mem_kv[li], m_kn_g[li])
        if li % 2 == 0:
            y = even_layer(h, km, vm, cos, sin, e_w_in[j], e_w_out[j], a_qn_g[j], a_kn_g[j], m_qn_g[li],
                           b_mu[j], b_w0[j], b_w2[j], b_a0[j], b_a2[j], b_k_k[j], b_k_a[j], b_r_k[j],
                           b_lnx_g[j], b_lnx_b[j])
        else:
            lb = jnp.maximum(lbs[j], 0.0)
            y = odd_layer(h, km, vm, cos, sin, li, lb, o_w_in[j], o_w_out[j], c_qn_g[j], c_kn_g[j],
                          c_lq1[j], c_lk1[j], c_lq2[j], c_lk2[j], c_subln_g[j], d_gn_g[j], m_qn_g[li])
        x = x + y
    return x
```

```cpp
#include <hip/hip_runtime.h>
#include <hip/hip_cooperative_groups.h>
#include <stdint.h>
#include <stdio.h>
namespace cg = cooperative_groups;

#define PROBE_SUB -1
#define PROBE_PAR 2
#ifndef ONE_LAUNCH
#define ONE_LAUNCH 1
#endif

typedef __attribute__((ext_vector_type(8))) short bf16x8;
typedef __attribute__((ext_vector_type(4))) float f32x4;
typedef __attribute__((ext_vector_type(2))) float f32x2;
typedef __attribute__((ext_vector_type(2))) __bf16 bf16x2_t;
typedef unsigned short u16;
typedef __attribute__((ext_vector_type(4))) unsigned u32x4;
#define DI __device__ __forceinline__

constexpr int DM = 1024, SEQ = 8192, NTOK = 16384;
constexpr int NP_EVEN = 2240, NP_ODD = 1792;
constexpr int RWKV_TQ = 2048;
constexpr int LS = 80;
constexpr int LSG = 144;

constexpr size_t OFF_WT_IN = 0;
constexpr size_t OFF_WT_OUT = OFF_WT_IN + (size_t)3648 * 1024 * 2;
constexpr size_t OFF_WT_KV = OFF_WT_OUT + (size_t)1024 * 1024 * 2;
constexpr size_t OFF_COS = OFF_WT_KV + (size_t)512 * 1024 * 2;
constexpr size_t OFF_SIN = OFF_COS + (size_t)SEQ * 8 * 4;
constexpr size_t OFF_HBUF = OFF_SIN + (size_t)SEQ * 8 * 4;
constexpr size_t OFF_MEMH = OFF_HBUF + (size_t)NTOK * 1024 * 2;
constexpr size_t OFF_KM = OFF_MEMH + (size_t)512 * 1024 * 2;
constexpr size_t OFF_VMT = OFF_KM + (size_t)2 * 4 * 256 * 64 * 2;
constexpr size_t OFF_PROJ = OFF_VMT + (size_t)2 * 256 * 256 * 2;
constexpr size_t OFF_QM = OFF_PROJ + (size_t)NTOK * NP_EVEN * 2;
constexpr size_t OFF_KMEAN = OFF_QM + (size_t)NTOK * 256 * 2;
constexpr size_t OFF_CTR = OFF_KMEAN + (size_t)2 * 6 * 32 * 64 * 4;
constexpr size_t OFF_X = OFF_CTR + 256;
constexpr size_t SZ_QE = (size_t)NTOK * 384 * 2;
constexpr size_t OFF_Q1E = OFF_X, OFF_K1E = OFF_Q1E + SZ_QE, OFF_VTE = OFF_K1E + SZ_QE;
constexpr size_t OFF_RW_R = OFF_VTE + SZ_QE, OFF_RW_K = OFF_RW_R + SZ_QE, OFF_RW_V = OFF_RW_K + SZ_QE,
                 OFF_RW_KK = OFF_RW_V + SZ_QE, OFF_RW_BV = OFF_RW_KK + SZ_QE, OFF_RW_W = OFF_RW_BV + SZ_QE;
constexpr size_t END_EVEN = OFF_RW_W + (size_t)NTOK * 384 * 4;
constexpr size_t SZ_QO = (size_t)NTOK * 512 * 2;
constexpr size_t OFF_Q1O = OFF_X, OFF_K1O = OFF_Q1O + SZ_QO, OFF_VTO = OFF_K1O + SZ_QO;
constexpr size_t OFF_HF = OFF_VTO + SZ_QO;
constexpr size_t OFF_RW_C = END_EVEN;
constexpr size_t OFF_BAR = OFF_RW_C + (size_t)NTOK * 8 * 4;
constexpr size_t OFF_YRAW = OFF_BAR + 16384;
constexpr size_t WS_NEEDED = OFF_YRAW + (size_t)NTOK * 384 * 2;
static_assert(OFF_HF + (size_t)NTOK * 256 * 4 <= END_EVEN, "odd-layer scratch overflows union region");

struct P {
  const float* in[32];
  float* out;
  char* ws;
};

DI u16 f2bf(float x) { uint32_t u = __float_as_uint(x); u += 0x7fffu + ((u >> 16) & 1u); return (u16)(u >> 16); }
DI float bf2f(u16 v) { return __uint_as_float(((uint32_t)v) << 16); }
DI uint32_t pk2(float a, float b) { f32x2 v = {a, b}; bf16x2_t r = __builtin_convertvector(v, bf16x2_t); return __builtin_bit_cast(uint32_t, r); }
DI uint2 pk4(float a, float b, float c, float d) { return make_uint2(pk2(a, b), pk2(c, d)); }
DI float bflo(uint32_t w) { return __uint_as_float(w << 16); }
DI float bfhi(uint32_t w) { return __uint_as_float(w & 0xffff0000u); }
DI float silu(float g) { return g / (1.f + __expf(-g)); }
DI float sigm(float g) { return 1.f / (1.f + __expf(-g)); }
template <int CTRL> DI float dppf0(float x) {
  return __builtin_bit_cast(float, __builtin_amdgcn_update_dpp(0, __builtin_bit_cast(int, x), CTRL, 0xF, 0xF, false));
}
DI float wsum(float x) {
  x += dppf0<0x128>(x); x += dppf0<0x124>(x); x += dppf0<0x122>(x); x += dppf0<0x121>(x);
  const float s0 = __builtin_bit_cast(float, __builtin_amdgcn_readlane(__builtin_bit_cast(int, x), 0));
  const float s1 = __builtin_bit_cast(float, __builtin_amdgcn_readlane(__builtin_bit_cast(int, x), 16));
  const float s2 = __builtin_bit_cast(float, __builtin_amdgcn_readlane(__builtin_bit_cast(int, x), 32));
  const float s3 = __builtin_bit_cast(float, __builtin_amdgcn_readlane(__builtin_bit_cast(int, x), 48));
  return (s0 + s1) + (s2 + s3);
}
template <int CTRL> DI float dppf(float x) {
  return __builtin_bit_cast(float, __builtin_amdgcn_update_dpp(0, __builtin_bit_cast(int, x), CTRL, 0xF, 0xF, false));
}
DI float allred16(float x) {
  x += dppf<0x128>(x); x += dppf<0x124>(x); x += dppf<0x122>(x); x += dppf<0x121>(x);
  return x;
}
DI void allred16_2(float& x, float& y) {
  x += dppf<0x128>(x); y += dppf<0x128>(y);
  x += dppf<0x124>(x); y += dppf<0x124>(y);
  x += dppf<0x122>(x); y += dppf<0x122>(y);
  x += dppf<0x121>(x); y += dppf<0x121>(y);
}
#define MFMA16(a, b, c) __builtin_amdgcn_mfma_f32_16x16x32_bf16((a), (b), (c), 0, 0, 0)

DI void transpose_w(const float* __restrict__ W, int N, u16* __restrict__ Wt, int tile, float* tl, int TIDX) {
  const int tid = TIDX;
  const int kt = tile & 15, nt = tile >> 4;
  const int k0 = kt * 64, n0 = nt * 64;
  __syncthreads();
  {
    const int r = tid >> 4, c4 = tid & 15;
#pragma unroll
    for (int rr = 0; rr < 4; ++rr) {
      int k = rr * 16 + r;
      float4 v = *(const float4*)(W + (size_t)(k0 + k) * N + n0 + c4 * 4);
      tl[k * 65 + c4 * 4 + 0] = v.x; tl[k * 65 + c4 * 4 + 1] = v.y; tl[k * 65 + c4 * 4 + 2] = v.z; tl[k * 65 + c4 * 4 + 3] = v.w;
    }
  }
  __syncthreads();
  {
    const int n = tid >> 2, kq = tid & 3;
    uint32_t w[8];
#pragma unroll
    for (int i = 0; i < 8; ++i) w[i] = pk2(tl[(kq * 16 + 2 * i) * 65 + n], tl[(kq * 16 + 2 * i + 1) * 65 + n]);
    uint4* dst = (uint4*)(Wt + (size_t)(n0 + n) * 1024 + k0 + kq * 16);
    dst[0] = make_uint4(w[0], w[1], w[2], w[3]);
    dst[1] = make_uint4(w[4], w[5], w[6], w[7]);
  }
}

DI void phase_norm(const P& p, int layer, char* smem, int TIDX) {
  const int tid = TIDX, lane = tid & 63, wave = tid >> 6;
  const int par = layer & 1, j = layer >> 1;
  const float* xin = (layer == 0) ? p.in[0] : p.out;
  u16* hbuf = (u16*)(p.ws + OFF_HBUF);
  u16* memh = (u16*)(p.ws + OFF_MEMH);
  const float* g1 = p.in[2] + layer * 1024;
  const float* g2 = p.in[3] + layer * 1024;
  const int nw = gridDim.x * 4;
  for (int row = blockIdx.x * 4 + wave; row < NTOK + 512; row += nw) {
    const float* src = row < NTOK ? xin + (size_t)row * 1024 : p.in[1] + (size_t)(row - NTOK) * 1024;
    const float* g = row < NTOK ? g1 : g2;
    u16* dst = row < NTOK ? hbuf + (size_t)row * 1024 : memh + (size_t)(row - NTOK) * 1024;
    float4 v[4];
    float ss = 0.f;
#pragma unroll
    for (int q = 0; q < 4; ++q) {
      v[q] = *(const float4*)(src + q * 256 + lane * 4);
      ss += v[q].x * v[q].x + v[q].y * v[q].y + v[q].z * v[q].z + v[q].w * v[q].w;
    }
    ss = wsum(ss);
    float rinv = rsqrtf(ss * (1.f / 1024.f) + 1e-6f);
#pragma unroll
    for (int q = 0; q < 4; ++q) {
      float4 gg = *(const float4*)(g + q * 256 + lane * 4);
      *(uint2*)(dst + q * 256 + lane * 4) = pk4(v[q].x * rinv * gg.x, v[q].y * rinv * gg.y, v[q].z * rinv * gg.z, v[q].w * rinv * gg.w);
    }
  }
  const int nin = par ? 3584 : 3648;
  const float* win = par ? p.in[21] + (size_t)j * 1024 * 3584 : p.in[7] + (size_t)j * 1024 * 3648;
  const float* wout = par ? p.in[22] + (size_t)j * 1024 * 1024 : p.in[8] + (size_t)j * 1024 * 1024;
  const float* wkv = p.in[4] + (size_t)layer * 1024 * 512;
  const int t_in = (nin / 64) * 16, t_out = 16 * 16, t_kv = 8 * 16;
  for (int t = blockIdx.x; t < t_in + t_out + t_kv; t += gridDim.x) {
    if (t < t_in) transpose_w(win, nin, (u16*)(p.ws + OFF_WT_IN), t, (float*)smem, TIDX);
    else if (t < t_in + t_out) transpose_w(wout, 1024, (u16*)(p.ws + OFF_WT_OUT), t - t_in, (float*)smem, TIDX);
    else transpose_w(wkv, 512, (u16*)(p.ws + OFF_WT_KV), t - t_in - t_out, (float*)smem, TIDX);
  }
  if (layer == 0) {
    float* ct = (float*)(p.ws + OFF_COS);
    float* st = (float*)(p.ws + OFF_SIN);
    for (int e = blockIdx.x * 256 + tid; e < SEQ * 8; e += gridDim.x * 256) {
      int pos = e >> 3, i = e & 7;
      float inv = 1.0f / powf(500000.0f, (float)(2 * i) / 16.0f);
      float ang = (float)pos * inv;
      float s, c;
      sincosf(ang, &s, &c);
      ct[e] = c; st[e] = s;
    }
  }
}

DI void gemm_mainloop(const u16* __restrict__ A, int lda, int m0, const u16* __restrict__ Bt, int ldb, int n0, int N, int K,
                      u16* As, u16* Bs, f32x4 (&acc)[4][4], int TIDX) {
  const int tid = TIDX, lane = tid & 63, wave = tid >> 6;
  const int wm = wave >> 1, wn = wave & 1;
  const int r16 = lane & 15, quad = lane >> 4;
  u32x4 ra[8], rb[8];
#pragma unroll
  for (int a = 0; a < 4; ++a)
#pragma unroll
    for (int b = 0; b < 4; ++b) acc[a][b] = (f32x4){0.f, 0.f, 0.f, 0.f};
  const int srow = tid >> 4, skc = tid & 15;
#pragma unroll
  for (int jj = 0; jj < 8; ++jj) {
    int row = srow + 16 * jj;
    ra[jj] = *(const u32x4*)(A + (size_t)(m0 + row) * lda + skc * 8);
    int n = n0 + row;
    rb[jj] = (n < N) ? *(const u32x4*)(Bt + (size_t)n * ldb + skc * 8) : (u32x4){0u, 0u, 0u, 0u};
  }
  for (int k0 = 0; k0 < K; k0 += 128) {
    __syncthreads();
#pragma unroll
    for (int jj = 0; jj < 8; ++jj) {
      int row = srow + 16 * jj;
      *(u32x4*)(As + row * LSG + skc * 8) = ra[jj];
      *(u32x4*)(Bs + row * LSG + skc * 8) = rb[jj];
    }
    __syncthreads();
    if (k0 + 128 < K) {
#pragma unroll
      for (int jj = 0; jj < 8; ++jj) {
        int row = srow + 16 * jj;
        ra[jj] = *(const u32x4*)(A + (size_t)(m0 + row) * lda + k0 + 128 + skc * 8);
        int n = n0 + row;
        rb[jj] = (n < N) ? *(const u32x4*)(Bt + (size_t)n * ldb + k0 + 128 + skc * 8) : (u32x4){0u, 0u, 0u, 0u};
      }
    }
#pragma unroll
    for (int kk = 0; kk < 4; ++kk) {
      bf16x8 af[4], bfr[4];
#pragma unroll
      for (int mt = 0; mt < 4; ++mt) af[mt] = *(const bf16x8*)(As + (wm * 64 + mt * 16 + r16) * LSG + kk * 32 + quad * 8);
#pragma unroll
      for (int nt = 0; nt < 4; ++nt) bfr[nt] = *(const bf16x8*)(Bs + (wn * 64 + nt * 16 + r16) * LSG + kk * 32 + quad * 8);
#pragma unroll
      for (int mt = 0; mt < 4; ++mt)
#pragma unroll
        for (int nt = 0; nt < 4; ++nt) acc[mt][nt] = MFMA16(bfr[nt], af[mt], acc[mt][nt]);
    }
  }
}

constexpr int ELS = 72;
DI u16* epi_region(char* smem, int TIDX) { return (u16*)smem + (TIDX >> 6) * (64 * ELS); }
template <class F> DI void epi_flush_rows(const u16* W, F rowptr, int TIDX) {
  const int lane = TIDX & 63;
#pragma unroll
  for (int it = 0; it < 8; ++it) {
    const int row = it * 8 + (lane >> 3), ch = lane & 7;
    const u32x4 v = *(const u32x4*)(W + row * ELS + ch * 8);
    *(u32x4*)(rowptr(row) + ch * 8) = v;
  }
}
DI void epi_qk(f32x4 (&acc)[4][4], int rowbase, int SL, int H, int head, const float* __restrict__ gain, bool rope,
               const float* __restrict__ ct, const float* __restrict__ st, u16* __restrict__ dst, char* smem, int TIDX) {
  const int lane = TIDX & 63, r16 = lane & 15, quad = lane >> 4;
  u16* W = epi_region(smem, TIDX);
  float gv[4][4];
#pragma unroll
  for (int nt = 0; nt < 4; ++nt)
#pragma unroll
    for (int i = 0; i < 4; ++i) gv[nt][i] = gain[nt * 16 + quad * 4 + i];
#pragma unroll
  for (int mt = 0; mt < 4; ++mt) {
    const int row = rowbase + mt * 16 + r16;
    const int b = row / SL, s = row - b * SL;
    float ss = 0.f;
#pragma unroll
    for (int nt = 0; nt < 4; ++nt)
#pragma unroll
      for (int i = 0; i < 4; ++i) ss += acc[mt][nt][i] * acc[mt][nt][i];
    ss += __shfl_xor(ss, 16);
    ss += __shfl_xor(ss, 32);
    const float rinv = rsqrtf(ss * (1.f / 64.f) + 1e-6f);
#pragma unroll
    for (int nt = 0; nt < 4; ++nt) {
      float v[4];
#pragma unroll
      for (int i = 0; i < 4; ++i) v[i] = acc[mt][nt][i] * rinv * gv[nt][i];
      if (nt == 0 && rope) {
#pragma unroll
        for (int i = 0; i < 4; ++i) {
          float pr = __shfl_xor(v[i], 32);
          int idx = (quad & 1) * 4 + i;
          float c = ct[s * 8 + idx], sn = st[s * 8 + idx];
          v[i] = (quad < 2) ? (v[i] * c - pr * sn) : (pr * sn + v[i] * c);
        }
      }
      *(uint2*)(W + (mt * 16 + r16) * ELS + nt * 16 + quad * 4) = pk4(v[0], v[1], v[2], v[3]);
    }
  }
  const int b0 = rowbase / SL, s0 = rowbase - b0 * SL;
  u16* base = dst + ((size_t)(b0 * H + head) * SL + s0) * 64;
  epi_flush_rows(W, [&](int r) { return base + (size_t)r * 64; }, TIDX);
}
DI void epi_vt(f32x4 (&acc)[4][4], int rowbase, int SL, int Wd, int colbase, u16* __restrict__ dst, char* smem, int TIDX) {
  const int lane = TIDX & 63, r16 = lane & 15, quad = lane >> 4;
  u16* W = epi_region(smem, TIDX);
#pragma unroll
  for (int mt = 0; mt < 4; ++mt)
#pragma unroll
    for (int nt = 0; nt < 4; ++nt)
#pragma unroll
      for (int i = 0; i < 4; ++i) W[(nt * 16 + quad * 4 + i) * ELS + mt * 16 + r16] = f2bf(acc[mt][nt][i]);
  const int b0 = rowbase / SL, s0 = rowbase - b0 * SL;
  u16* base = dst + ((size_t)b0 * Wd + colbase) * SL + s0;
  epi_flush_rows(W, [&](int c) { return base + (size_t)c * SL; }, TIDX);
}
DI void epi_plain(f32x4 (&acc)[4][4], int rowbase, int NP, int dcol, u16* __restrict__ proj, char* smem, int TIDX) {
  const int lane = TIDX & 63, r16 = lane & 15, quad = lane >> 4;
  u16* W = epi_region(smem, TIDX);
#pragma unroll
  for (int mt = 0; mt < 4; ++mt)
#pragma unroll
    for (int nt = 0; nt < 4; ++nt)
      *(uint2*)(W + (mt * 16 + r16) * ELS + nt * 16 + quad * 4) = pk4(acc[mt][nt][0], acc[mt][nt][1], acc[mt][nt][2], acc[mt][nt][3]);
  u16* base = proj + (size_t)rowbase * NP + dcol;
  epi_flush_rows(W, [&](int r) { return base + (size_t)r * NP; }, TIDX);
}

DI void epi_fgate(f32x4 (&acc)[4][4], int rowbase, int colbase, int jodd, const float* __restrict__ dlb, float* __restrict__ dst, int TIDX) {
  const int lane = TIDX & 63, r16 = lane & 15, quad = lane >> 4;
  float lb[4][4];
#pragma unroll
  for (int nt = 0; nt < 4; ++nt)
#pragma unroll
    for (int i = 0; i < 4; ++i) {
      const int c = colbase + nt * 16 + quad * 4 + i;
      lb[nt][i] = (jodd == 1) ? fmaxf(sigm(dlb[256 + c] - dlb[c]), 0.f) : 0.f;
    }
#pragma unroll
  for (int mt = 0; mt < 4; ++mt) {
    const int row = rowbase + mt * 16 + r16;
#pragma unroll
    for (int nt = 0; nt < 4; ++nt) {
      float4 o;
      o.x = lb[nt][0] + (1.f - lb[nt][0]) * sigm(acc[mt][nt][0]);
      o.y = lb[nt][1] + (1.f - lb[nt][1]) * sigm(acc[mt][nt][1]);
      o.z = lb[nt][2] + (1.f - lb[nt][2]) * sigm(acc[mt][nt][2]);
      o.w = lb[nt][3] + (1.f - lb[nt][3]) * sigm(acc[mt][nt][3]);
      *(float4*)(dst + (size_t)row * 256 + colbase + nt * 16 + quad * 4) = o;
    }
  }
}

DI void phase_gemm_in(const P& p, int layer, char* smem, int part, int widx, int nwa, int TIDX) {
  const int par = layer & 1, j = layer >> 1;
  const int wave = TIDX >> 6, wm = wave >> 1, wn = wave & 1;
  u16* As = (u16*)smem;
  u16* Bs = As + 128 * LSG;
  const int N = par ? 3584 : 3648;
  const int NT = par ? 28 : 29;
  const int NU = par ? 56 : 57;
  const int NP = par ? NP_ODD : NP_EVEN;
  const int main_tiles = 128 * NT;
  const float* ct = (const float*)(p.ws + OFF_COS);
  const float* st = (const float*)(p.ws + OFF_SIN);
  u16* proj = (u16*)(p.ws + OFF_PROJ);
  u16* Q1 = (u16*)(p.ws + (par ? OFF_Q1O : OFF_Q1E));
  u16* K1 = (u16*)(p.ws + (par ? OFF_K1O : OFF_K1E));
  u16* VT = (u16*)(p.ws + (par ? OFF_VTO : OFF_VTE));
  u16* QM = (u16*)(p.ws + OFF_QM);
  const int nnt = (part == 0) ? NT : (part == 1 ? 10 : NT - 10);
  const int ntile = 128 * nnt + (part == 1 ? 0 : 16);
  for (int q = (part == 2) ? widx : (int)blockIdx.x; q < ntile; q += (part == 2) ? nwa : (int)gridDim.x) {
    asm volatile("" : "+v"(TIDX));
    int t, mi = 0, ni = 0;
    if (q < 128 * nnt) {
      const int grp = q / (8 * nnt), r = q - grp * (8 * nnt);
      const int nj = r >> 3;
      mi = grp * 8 + (r & 7);
      ni = (part == 0) ? nj : (part == 1 ? nj + 12 : (nj < 12 ? nj : nj + 10));
      t = 0;
    } else {
      t = main_tiles + (q - 128 * nnt);
    }
    f32x4 acc[4][4];
    if (t < main_tiles) {
      const int m0 = mi * 128, n0 = ni * 128;
      gemm_mainloop((const u16*)(p.ws + OFF_HBUF), 1024, m0, (const u16*)(p.ws + OFF_WT_IN), 1024, n0, N, 1024, As, Bs, acc, TIDX);
      const int u = (n0 >> 6) + wn;
      const int rowbase = m0 + wm * 64;
      __syncthreads();
      if (u < NU) {
        if (!par) {
          if (u < 6) epi_qk(acc, rowbase, SEQ, 6, u, p.in[9] + j * 64, true, ct, st, Q1, smem, TIDX);
          else if (u < 12) epi_qk(acc, rowbase, SEQ, 6, u - 6, p.in[10] + j * 64, true, ct, st, K1, smem, TIDX);
          else if (u < 18) epi_vt(acc, rowbase, SEQ, 384, (u - 12) * 64, VT, smem, TIDX);
          else if (u < 49) epi_plain(acc, rowbase, NP, (u - 18) * 64, proj, smem, TIDX);
          else if (u < 53) epi_qk(acc, rowbase, SEQ, 4, u - 49, p.in[5] + layer * 64, false, ct, st, QM, smem, TIDX);
          else epi_plain(acc, rowbase, NP, (u - 22) * 64, proj, smem, TIDX);
        } else {
          if (u < 8) epi_qk(acc, rowbase, SEQ, 8, u, p.in[23] + j * 64, true, ct, st, Q1, smem, TIDX);
          else if (u < 16) epi_qk(acc, rowbase, SEQ, 8, u - 8, p.in[24] + j * 64, true, ct, st, K1, smem, TIDX);
          else if (u < 24) epi_vt(acc, rowbase, SEQ, 512, (u - 16) * 64, VT, smem, TIDX);
          else if (u >= 36 && u < 40) epi_fgate(acc, rowbase, (u - 36) * 64, j, p.in[30], (float*)(p.ws + OFF_HF), TIDX);
          else if (u < 48) epi_plain(acc, rowbase, NP, (u - 24) * 64, proj, smem, TIDX);
          else if (u < 52) epi_qk(acc, rowbase, SEQ, 4, u - 48, p.in[5] + layer * 64, false, ct, st, QM, smem, TIDX);
          else epi_plain(acc, rowbase, NP, (u - 28) * 64, proj, smem, TIDX);
        }
      }
    } else {
      const int tt = t - main_tiles;
      const int mi = tt >> 2, ni = tt & 3;
      const int m0 = mi * 128, n0 = ni * 128;
      gemm_mainloop((const u16*)(p.ws + OFF_MEMH), 1024, m0, (const u16*)(p.ws + OFF_WT_KV), 1024, n0, 512, 1024, As, Bs, acc, TIDX);
      const int u = (n0 >> 6) + wn;
      const int rowbase = m0 + wm * 64;
      __syncthreads();
      if (u < 4) epi_qk(acc, rowbase, 256, 4, u, p.in[6] + layer * 64, false, ct, st, (u16*)(p.ws + OFF_KM), smem, TIDX);
      else epi_vt(acc, rowbase, 256, 256, (u - 4) * 64, (u16*)(p.ws + OFF_VMT), smem, TIDX);
    }
  }
}

DI void phase_gemm_out(const P& p, int layer, char* smem, int TIDX) {
  const int lane = TIDX & 63, wave = TIDX >> 6, wm = wave >> 1, wn = wave & 1;
  const int r16 = lane & 15, quad = lane >> 4;
  u16* As = (u16*)smem;
  u16* Bs = As + 128 * LSG;
  const float* xin = (layer == 0) ? p.in[0] : p.out;
  float* xout = p.out;
  const int xcd = blockIdx.x & 7, xlocal = blockIdx.x >> 3, xnl = gridDim.x >> 3;
  for (int idx = xlocal; idx < 2 * 64; idx += xnl) {
    f32x4 acc[4][4];
    const int sidx = (idx >> 6) * 8 + xcd, within = idx & 63;
    const int mi = sidx * 8 + (within >> 3), ni = within & 7;
    const int m0 = mi * 128, n0 = ni * 128;
    gemm_mainloop((const u16*)(p.ws + OFF_HBUF), 1024, m0, (const u16*)(p.ws + OFF_WT_OUT), 1024, n0, 1024, 1024, As, Bs, acc, TIDX);
#pragma unroll
    for (int mt = 0; mt < 4; ++mt) {
      const int row = m0 + wm * 64 + mt * 16 + r16;
#pragma unroll
      for (int nt = 0; nt < 4; ++nt) {
        const size_t o = (size_t)row * 1024 + n0 + wn * 64 + nt * 16 + quad * 4;
        float4 xv = *(const float4*)(xin + o);
        xv.x += acc[mt][nt][0]; xv.y += acc[mt][nt][1]; xv.z += acc[mt][nt][2]; xv.w += acc[mt][nt][3];
        *(float4*)(xout + o) = xv;
      }
    }
  }
}

DI void phase_prep_even(const P& p, int layer, char* smem, int mode, int widx, int nwa, int TIDX) {
  const int tid = TIDX, lane = tid & 63, wave = tid >> 6;
  const int j = layer >> 1;
  const u16* proj = (const u16*)(p.ws + OFF_PROJ);
  const int NP = NP_EVEN;
  float* lds = (float*)smem;
  const int n_rw = 256 * 6, n_km = 2 * 6 * 32;
  constexpr int GE = RWKV_TQ / 64;
  const int n_early = 2 * GE * 6, n_late = n_rw - n_early;
  const int i_lo = 0, i_hi = (mode == 0) ? n_early : (mode == 2 ? n_late : n_km);
  for (int it0 = i_lo + (mode ? widx : (int)blockIdx.x); it0 < i_hi; it0 += (mode ? nwa : (int)gridDim.x)) {
    asm volatile("" : "+v"(TIDX));
    int item;
    if (mode == 1) item = n_rw + it0;
    else {
      const int hd_ = it0 % 6, gi = it0 / 6;
      int grp_;
      if (mode == 0) grp_ = (gi / GE) * 128 + (gi % GE);
      else grp_ = (gi / (128 - GE)) * 128 + GE + (gi % (128 - GE));
      item = grp_ * 6 + hd_;
    }
    __syncthreads();
    if (item < n_rw) {
      const int grp = item / 6, hd = item - grp * 6;
      const int tok0 = grp * 64;
      const float* mu = p.in[11] + j * 1216;
#pragma unroll
      for (int q = 0; q < 16; ++q) {
        int e = tid + 256 * q;
        int tk = e >> 6, c = e & 63;
        int tok = tok0 + tk;
        float cur = bf2f(proj[(size_t)tok * NP + 1536 + c]);
        float prev = ((tok & (SEQ - 1)) == 0) ? 0.f : bf2f(proj[(size_t)(tok - 1) * NP + 1536 + c]);
        float sh = cur + (prev - cur) * mu[1152 + c];
        if (c < 32) sh = 1.f - 2.f / (__expf(2.f * sh) + 1.f);
        lds[tk * 64 + c] = sh;
      }
      __syncthreads();
      const int c = lane, tg = wave, ch = hd * 64 + c;
      float w2c[32], a2c[32];
      const float* w2 = p.in[13] + (size_t)j * 32 * 384;
      const float* a2 = p.in[15] + (size_t)j * 32 * 384;
#pragma unroll
      for (int q = 0; q < 32; ++q) { w2c[q] = w2[q * 384 + ch]; a2c[q] = a2[q * 384 + ch]; }
      const float w0c = p.in[12][j * 384 + ch], a0c = p.in[14][j * 384 + ch];
      const float kkc = p.in[16][j * 384 + ch], kac = p.in[17][j * 384 + ch];
      const float mur = mu[ch], muk = mu[384 + ch], muv = mu[768 + ch];
      int tokf = tok0 + tg * 16;
      float pr = 0.f, pk = 0.f, pv = 0.f;
      if ((tokf & (SEQ - 1)) != 0) {
        pr = bf2f(proj[(size_t)(tokf - 1) * NP + 384 + ch]);
        pk = bf2f(proj[(size_t)(tokf - 1) * NP + 768 + ch]);
        pv = bf2f(proj[(size_t)(tokf - 1) * NP + 1152 + ch]);
      }
      u16* RR = (u16*)(p.ws + OFF_RW_R); u16* RK = (u16*)(p.ws + OFF_RW_K); u16* RV = (u16*)(p.ws + OFF_RW_V);
      u16* RKK = (u16*)(p.ws + OFF_RW_KK); u16* RBV = (u16*)(p.ws + OFF_RW_BV); float* RW = (float*)(p.ws + OFF_RW_W);
      float* RC = (float*)(p.ws + OFF_RW_C);
      float ck_cur = bf2f(proj[(size_t)tokf * NP + 768 + ch]);
      float ksh_cur = ck_cur + (pk - ck_cur) * muk;
      float kkn_cur;
      {
        float kk0 = ksh_cur * kkc;
        float ssq0 = wsum(kk0 * kk0);
        kkn_cur = bf2f(f2bf(kk0 * rsqrtf(fmaxf(ssq0, 1e-24f))));
      }
      float cr_c[4], ck_c[4], cv_c[4];
#pragma unroll
      for (int i = 0; i < 4; ++i) {
        cr_c[i] = bf2f(proj[(size_t)(tokf + i) * NP + 384 + ch]);
        ck_c[i] = bf2f(proj[(size_t)(tokf + i) * NP + 768 + ch]);
        cv_c[i] = bf2f(proj[(size_t)(tokf + i) * NP + 1152 + ch]);
      }
      for (int g4 = 0; g4 < 4; ++g4) {
        float cr_n[4], ck_n4[4], cv_n[4];
#pragma unroll
        for (int i = 0; i < 4; ++i) {
          int tn = tokf + 4 * (g4 + 1) + i;
          tn = tn < NTOK ? tn : NTOK - 1;
          cr_n[i] = bf2f(proj[(size_t)tn * NP + 384 + ch]);
          ck_n4[i] = bf2f(proj[(size_t)tn * NP + 768 + ch]);
          cv_n[i] = bf2f(proj[(size_t)tn * NP + 1152 + ch]);
        }
#pragma unroll
        for (int i = 0; i < 4; ++i) {
          const int tt = g4 * 4 + i;
          const int tok = tokf + tt, tk = tg * 16 + tt;
          const float cr = cr_c[i], cv = cv_c[i];
          float r = cr + (pr - cr) * mur, v = cv + (pv - cv) * muv;
          const float k = ksh_cur;
          pr = cr; pv = cv;
          float ck_n = 0.f, ksh_n = 0.f, kkn_n = 0.f;
          if (((tok + 1) & (SEQ - 1)) != 0) {
            ck_n = (i < 3) ? ck_c[(i + 1) & 3] : ck_n4[0];
            ksh_n = ck_n + (ck_cur - ck_n) * muk;
            float kk1 = ksh_n * kkc;
            float ssq1 = wsum(kk1 * kk1);
            kkn_n = bf2f(f2bf(kk1 * rsqrtf(fmaxf(ssq1, 1e-24f))));
          }
          float dw = 0.f, da = 0.f;
#pragma unroll
          for (int q = 0; q < 8; ++q) {
            float4 l1 = *(const float4*)(lds + tk * 64 + q * 4);
            float4 l2 = *(const float4*)(lds + tk * 64 + 32 + q * 4);
            dw += l1.x * w2c[q * 4] + l1.y * w2c[q * 4 + 1] + l1.z * w2c[q * 4 + 2] + l1.w * w2c[q * 4 + 3];
            da += l2.x * a2c[q * 4] + l2.y * a2c[q * 4 + 1] + l2.z * a2c[q * 4 + 2] + l2.w * a2c[q * 4 + 3];
          }
          float win = w0c + dw;
          float z = -win;
          float sp = (z > 20.f) ? z : log1pf(__expf(z));
          float wlog = -sp - 0.5f;
          float decay = __expf(-__expf(wlog));
          float asig = sigm(a0c + da);
          float kmod = k * (1.f + (asig - 1.f) * kac);
          const float bv = bf2f(f2bf(kkn_cur * asig));
          const float cdot = wsum(bv * kkn_n);
          const size_t o = (size_t)tok * 384 + ch;
          RR[o] = f2bf(r); RK[o] = f2bf(kmod); RV[o] = f2bf(v); RKK[o] = f2bf(kkn_n); RBV[o] = f2bf(bv); RW[o] = decay;
          if (lane == 0) RC[(size_t)tok * 8 + hd] = cdot;
          ck_cur = ck_n; ksh_cur = ksh_n; kkn_cur = kkn_n;
        }
#pragma unroll
        for (int i = 0; i < 4; ++i) { cr_c[i] = cr_n[i]; ck_c[i] = ck_n4[i]; cv_c[i] = cv_n[i]; }
      }
    } else {
      const int it = item - n_rw;
      const int bh = it >> 5, blk = it & 31;
      const u16* K1 = (const u16*)(p.ws + OFF_K1E) + ((size_t)bh * SEQ + blk * 256) * 64;
      const int d8 = tid & 7, kr = tid >> 3;
      float a[8] = {0.f, 0.f, 0.f, 0.f, 0.f, 0.f, 0.f, 0.f};
#pragma unroll
      for (int q = 0; q < 8; ++q) {
        uint4 v = *(const uint4*)(K1 + (size_t)(kr * 8 + q) * 64 + d8 * 8);
        a[0] += bflo(v.x); a[1] += bfhi(v.x); a[2] += bflo(v.y); a[3] += bfhi(v.y);
        a[4] += bflo(v.z); a[5] += bfhi(v.z); a[6] += bflo(v.w); a[7] += bfhi(v.w);
      }
#pragma unroll
      for (int q = 0; q < 8; ++q) lds[kr * 64 + d8 * 8 + q] = a[q];
      __syncthreads();
      if (tid < 64) {
        float s = 0.f;
        for (int q = 0; q < 32; ++q) s += lds[q * 64 + tid];
        ((float*)(p.ws + OFF_KMEAN))[(size_t)it * 64 + tid] = s * (1.f / 256.f);
      }
    }
  }
}

DI float wmax(float x) {
  x = fmaxf(x, dppf0<0x128>(x)); x = fmaxf(x, dppf0<0x124>(x)); x = fmaxf(x, dppf0<0x122>(x)); x = fmaxf(x, dppf0<0x121>(x));
  const float s0 = __builtin_bit_cast(float, __builtin_amdgcn_readlane(__builtin_bit_cast(int, x), 0));
  const float s1 = __builtin_bit_cast(float, __builtin_amdgcn_readlane(__builtin_bit_cast(int, x), 16));
  const float s2 = __builtin_bit_cast(float, __builtin_amdgcn_readlane(__builtin_bit_cast(int, x), 32));
  const float s3 = __builtin_bit_cast(float, __builtin_amdgcn_readlane(__builtin_bit_cast(int, x), 48));
  return fmaxf(fmaxf(s0, s1), fmaxf(s2, s3));
}
DI float score_bound(const float* __restrict__ gq, const float* __restrict__ gk, int lane) {
  const float a = wmax(fabsf(gq[lane])), b = wmax(fabsf(gk[lane]));
  return 64.f * a * b * (0.125f * 1.4426950408889634f) * 1.02f + 0.25f;
}

template <int DV, int MODE>
DI void attn_pass(const u16* __restrict__ Qp, const u16* __restrict__ Kp, const u16* __restrict__ VTp, int ldv, int q0, int ntiles,
                  const short* list, unsigned selmask, int own, u16* Ks, u16* Vs, f32x4 (&o)[DV / 16], float& lsum, float M0, int TIDX) {
  const int tid = TIDX, lane = tid & 63, wave = tid >> 6;
  const int r16 = lane & 15, quad = lane >> 4;
  const float SC = 0.125f * 1.4426950408889634f;
  const u16* qrow = Qp + (size_t)(q0 + wave * 16 + r16) * 64;
  bf16x8 qf[2];
  qf[0] = *(const bf16x8*)(qrow + quad * 8);
  qf[1] = *(const bf16x8*)(qrow + 32 + quad * 8);
  float l = 0.f;
#pragma unroll
  for (int mt = 0; mt < DV / 16; ++mt) o[mt] = (f32x4){0.f, 0.f, 0.f, 0.f};
  const int qpos = q0 + wave * 16 + r16;
  const int srow = tid >> 3, sc8 = tid & 7;
  u32x4 rk[2], rv[DV / 32];
  auto key0_of = [&](int ti) -> int {
    if (MODE == 0) return ti == 0 ? q0 : (ti - 1) * 64;
    if (MODE == 1) return (int)list[ti] * 64;
    return ti * 64;
  };
  auto gload = [&](int key0) {
#pragma unroll
    for (int jj = 0; jj < 2; ++jj) rk[jj] = *(const u32x4*)(Kp + (size_t)(key0 + srow + 32 * jj) * 64 + sc8 * 8);
#pragma unroll
    for (int jj = 0; jj < DV / 32; ++jj) rv[jj] = *(const u32x4*)(VTp + (size_t)(srow + 32 * jj) * ldv + key0 + sc8 * 8);
  };
  gload(key0_of(0));
  for (int ti = 0; ti < ntiles; ++ti) {
    const int key0 = key0_of(ti);
    __syncthreads();
#pragma unroll
    for (int jj = 0; jj < 2; ++jj) {
      const int kap = srow + 32 * jj;
      const int rho = (kap & 32) | ((kap & 4) << 2) | ((kap >> 1) & 12) | (kap & 3);
      *(u32x4*)(Ks + rho * LS + sc8 * 8) = rk[jj];
    }
#pragma unroll
    for (int jj = 0; jj < DV / 32; ++jj) *(u32x4*)(Vs + (srow + 32 * jj) * LS + sc8 * 8) = rv[jj];
    __syncthreads();
    if (ti + 1 < ntiles) gload(key0_of(ti + 1));
    bool lanesel = true;
    if (MODE == 1) {
      const int n = key0 >> 8;
      lanesel = (n == own) || ((selmask >> n) & 1u);
      if (__builtin_amdgcn_ballot_w64(lanesel) == 0) continue;
    }
    const bool diag = (MODE != 2) && (key0 == q0);
    f32x4 s[2][2];
#pragma unroll
    for (int g = 0; g < 2; ++g)
#pragma unroll
      for (int u = 0; u < 2; ++u) {
        f32x4 a = {0.f, 0.f, 0.f, 0.f};
        const int krow = 32 * g + 16 * u + r16;
#pragma unroll
        for (int ds = 0; ds < 2; ++ds) {
          bf16x8 kf = *(const bf16x8*)(Ks + krow * LS + ds * 32 + quad * 8);
          a = MFMA16(kf, qf[ds], a);
        }
        s[g][u] = a;
      }
    float rs = 0.f;
#pragma unroll
    for (int g = 0; g < 2; ++g)
#pragma unroll
      for (int u = 0; u < 2; ++u)
#pragma unroll
        for (int i = 0; i < 4; ++i) {
          float v = s[g][u][i] * SC - M0;
          if (diag) {
            int kpos = key0 + 32 * g + 8 * quad + 4 * u + i;
            if (kpos > qpos) v = -1e30f;
          }
          if (MODE == 1) { if (!lanesel) v = -1e30f; }
          const float pv = __builtin_amdgcn_exp2f(v);
          s[g][u][i] = pv;
          rs += pv;
        }
    l += rs;
#pragma unroll
    for (int g = 0; g < 2; ++g) {
      uint4 pw = make_uint4(pk2(s[g][0][0], s[g][0][1]), pk2(s[g][0][2], s[g][0][3]), pk2(s[g][1][0], s[g][1][1]), pk2(s[g][1][2], s[g][1][3]));
      bf16x8 pf = __builtin_bit_cast(bf16x8, pw);
#pragma unroll
      for (int mt = 0; mt < DV / 16; ++mt) {
        bf16x8 vf = *(const bf16x8*)(Vs + (mt * 16 + r16) * LS + g * 32 + quad * 8);
        o[mt] = MFMA16(vf, pf, o[mt]);
      }
    }
  }
  l += __shfl_xor(l, 16);
  l += __shfl_xor(l, 32);
  lsum = l;
}

struct AttnSmem {
  u16 Ks[64 * LS];
  u16 Vs[128 * LS];
  float kmean[32 * 64];
  unsigned sel[64];
  unsigned ormask;
  int ntl;
  short list[128];
};

DI void moba_tile(const P& p, int layer, int item, AttnSmem* sm, int TIDX) {
  const int tid = TIDX, lane = tid & 63, wave = tid >> 6, r16 = lane & 15, quad = lane >> 4;
  const int qt = 127 - item / 12, bh = item % 12;
  const int b = bh / 6, h = bh - b * 6;
  const int q0 = qt * 64, own = q0 >> 8;
  const u16* Q1 = (const u16*)(p.ws + OFF_Q1E) + (size_t)bh * SEQ * 64;
  const u16* K1 = (const u16*)(p.ws + OFF_K1E) + (size_t)bh * SEQ * 64;
  const u16* VT = (const u16*)(p.ws + OFF_VTE) + (size_t)bh * 64 * SEQ;
  const float* kmean = (const float*)(p.ws + OFF_KMEAN) + (size_t)bh * 32 * 64;
  __syncthreads();
  for (int e = tid; e < own * 64; e += 256) sm->kmean[e] = kmean[e];
  if (tid == 0) sm->ormask = 0u;
  __syncthreads();
  {
    const int q = tid >> 2, sub = tid & 3;
    float gate[8];
#pragma unroll
    for (int jn = 0; jn < 8; ++jn) gate[jn] = 0.f;
    const u16* qr = Q1 + (size_t)(q0 + q) * 64;
#pragma unroll
    for (int c = 0; c < 8; ++c) {
      uint4 qv = *(const uint4*)(qr + c * 8);
      float qf[8] = {bflo(qv.x), bfhi(qv.x), bflo(qv.y), bfhi(qv.y), bflo(qv.z), bfhi(qv.z), bflo(qv.w), bfhi(qv.w)};
#pragma unroll
      for (int jn = 0; jn < 8; ++jn) {
        const int n = sub + 4 * jn;
        if (n < own) {
          float4 k0 = *(const float4*)(sm->kmean + n * 64 + c * 8);
          float4 k1 = *(const float4*)(sm->kmean + n * 64 + c * 8 + 4);
          gate[jn] += qf[0] * k0.x + qf[1] * k0.y + qf[2] * k0.z + qf[3] * k0.w + qf[4] * k1.x + qf[5] * k1.y + qf[6] * k1.z + qf[7] * k1.w;
        }
      }
    }
    unsigned selm = 0u;
#pragma unroll
    for (int round = 0; round < 3; ++round) {
      float best = -3e38f;
      int bidx = 999;
#pragma unroll
      for (int jn = 0; jn < 8; ++jn) {
        const int n = sub + 4 * jn;
        if (n < own && !((selm >> n) & 1u) && gate[jn] > best) { best = gate[jn]; bidx = n; }
      }
#pragma unroll
      for (int off = 1; off <= 2; off <<= 1) {
        float ob = __shfl_xor(best, off);
        int oi = __shfl_xor(bidx, off);
        if (ob > best || (ob == best && oi < bidx)) { best = ob; bidx = oi; }
      }
      if (bidx < own) selm |= 1u << bidx;
    }
    if (sub == 0) { sm->sel[q] = selm; atomicOr(&sm->ormask, selm); }
  }
  __syncthreads();
  if (tid == 0) {
    int n = 0;
    sm->list[n++] = (short)(q0 >> 6);
    for (int kt = own * 4; kt < (q0 >> 6); ++kt) sm->list[n++] = (short)kt;
    const unsigned om = sm->ormask;
    for (int blk = 0; blk < own; ++blk)
      if ((om >> blk) & 1u) { for (int q = 0; q < 4; ++q) sm->list[n++] = (short)(blk * 4 + q); }
    sm->ntl = n;
  }
  __syncthreads();
  const unsigned selmask = sm->sel[wave * 16 + r16];
  const int ntiles = sm->ntl;
  f32x4 o[4];
  float l;
  const float M0 = score_bound(p.in[9] + (layer >> 1) * 64, p.in[10] + (layer >> 1) * 64, lane);
  attn_pass<64, 1>(Q1, K1, VT, SEQ, q0, ntiles, sm->list, selmask, own, sm->Ks, sm->Vs, o, l, M0, TIDX);
  const float inv = 1.f / l;
  const int tok = b * SEQ + q0 + wave * 16 + r16;
  const u16* proj = (const u16*)(p.ws + OFF_PROJ);
  u16* mixed = (u16*)(p.ws + OFF_HBUF);
#pragma unroll
  for (int mt = 0; mt < 4; ++mt) {
    const int dv = mt * 16 + quad * 4;
    uint2 gw = *(const uint2*)(proj + (size_t)tok * NP_EVEN + h * 64 + dv);
    float g0 = bflo(gw.x), g1 = bfhi(gw.x), g2 = bflo(gw.y), g3 = bfhi(gw.y);
    *(uint2*)(mixed + (size_t)tok * 1024 + h * 64 + dv) =
        pk4(o[mt][0] * inv * silu(g0), o[mt][1] * inv * silu(g1), o[mt][2] * inv * silu(g2), o[mt][3] * inv * silu(g3));
  }
}

DI void mem_tile(const P& p, int layer, int item, AttnSmem* sm, int TIDX) {
  const int tid = TIDX, lane = tid & 63, wave = tid >> 6, r16 = lane & 15, quad = lane >> 4;
  const int par = layer & 1;
  const int qt = item >> 3, bh = item & 7;
  const int b = bh >> 2, h = bh & 3;
  const int q0 = qt * 64;
  const u16* QM = (const u16*)(p.ws + OFF_QM) + (size_t)bh * SEQ * 64;
  const u16* KM = (const u16*)(p.ws + OFF_KM) + (size_t)bh * 256 * 64;
  const u16* VMT = (const u16*)(p.ws + OFF_VMT) + (size_t)(b * 256 + h * 64) * 256;
  f32x4 o[4];
  float l;
  const float M0 = score_bound(p.in[5] + layer * 64, p.in[6] + layer * 64, lane);
  attn_pass<64, 2>(QM, KM, VMT, 256, q0, 4, nullptr, 0u, 0, sm->Ks, sm->Vs, o, l, M0, TIDX);
  const float inv = 1.f / l;
  const int tok = b * SEQ + q0 + wave * 16 + r16;
  const int NP = par ? NP_ODD : NP_EVEN;
  const int gcol = par ? 1536 : 1984;
  const u16* proj = (const u16*)(p.ws + OFF_PROJ);
  u16* mixed = (u16*)(p.ws + OFF_HBUF);
#pragma unroll
  for (int mt = 0; mt < 4; ++mt) {
    const int dv = mt * 16 + quad * 4;
    uint2 gw = *(const uint2*)(proj + (size_t)tok * NP + gcol + h * 64 + dv);
    float g0 = bflo(gw.x), g1 = bfhi(gw.x), g2 = bflo(gw.y), g3 = bfhi(gw.y);
    *(uint2*)(mixed + (size_t)tok * 1024 + 768 + h * 64 + dv) =
        pk4(o[mt][0] * inv * silu(g0), o[mt][1] * inv * silu(g1), o[mt][2] * inv * silu(g2), o[mt][3] * inv * silu(g3));
  }
}

DI void diff_tile(const P& p, int layer, int item, AttnSmem* sm, int TIDX) {
  const int tid = TIDX, lane = tid & 63, wave = tid >> 6, r16 = lane & 15, quad = lane >> 4;
  const int j = layer >> 1;
  const int qt = 127 - (item >> 3), bh = item & 7;
  const int b = bh >> 2, h = bh & 3;
  const int q0 = qt * 64;
  const u16* VT = (const u16*)(p.ws + OFF_VTO) + (size_t)(b * 512 + h * 128) * SEQ;
  f32x4 o1[8], o[8];
  float l;
  const float M0 = score_bound(p.in[23] + j * 64, p.in[24] + j * 64, lane);
  {
    const u16* Q1 = (const u16*)(p.ws + OFF_Q1O) + (size_t)(b * 8 + h * 2 + 0) * SEQ * 64;
    const u16* K1 = (const u16*)(p.ws + OFF_K1O) + (size_t)(b * 8 + h * 2 + 0) * SEQ * 64;
    attn_pass<128, 0>(Q1, K1, VT, SEQ, q0, qt + 1, nullptr, 0u, 0, sm->Ks, sm->Vs, o1, l, M0, TIDX);
    const float inv = 1.f / l;
#pragma unroll
    for (int mt = 0; mt < 8; ++mt) { o1[mt][0] *= inv; o1[mt][1] *= inv; o1[mt][2] *= inv; o1[mt][3] *= inv; }
  }
  {
    const u16* Q1 = (const u16*)(p.ws + OFF_Q1O) + (size_t)(b * 8 + h * 2 + 1) * SEQ * 64;
    const u16* K1 = (const u16*)(p.ws + OFF_K1O) + (size_t)(b * 8 + h * 2 + 1) * SEQ * 64;
    attn_pass<128, 0>(Q1, K1, VT, SEQ, q0, qt + 1, nullptr, 0u, 0, sm->Ks, sm->Vs, o, l, M0, TIDX);
  }
  int lv = layer;
  asm volatile("" : "+s"(lv));
  const float lam_init = 0.8f - 0.6f * __expf(-0.3f * (float)lv);
  float lam;
  {
    float a = p.in[25][j * 64 + lane] * p.in[26][j * 64 + lane];
    float c = p.in[27][j * 64 + lane] * p.in[28][j * 64 + lane];
    a = wsum(a); c = wsum(c);
    lam = __expf(a) - __expf(c) + lam_init;
  }
  const float inv2 = lam / l;
  float ss = 0.f;
#pragma unroll
  for (int mt = 0; mt < 8; ++mt)
#pragma unroll
    for (int i = 0; i < 4; ++i) { float v = o1[mt][i] - inv2 * o[mt][i]; o1[mt][i] = v; ss += v * v; }
  ss += __shfl_xor(ss, 16);
  ss += __shfl_xor(ss, 32);
  const float rinv = rsqrtf(ss * (1.f / 128.f) + 1e-6f) * (1.f - lam_init);
  const int tok = b * SEQ + q0 + wave * 16 + r16;
  const u16* proj = (const u16*)(p.ws + OFF_PROJ);
  u16* mixed = (u16*)(p.ws + OFF_HBUF);
  const float* sg = p.in[29] + j * 128;
#pragma unroll
  for (int mt = 0; mt < 8; ++mt) {
    const int dv = mt * 16 + quad * 4;
    uint2 gw = *(const uint2*)(proj + (size_t)tok * NP_ODD + h * 128 + dv);
    float g0 = bflo(gw.x), g1 = bfhi(gw.x), g2 = bflo(gw.y), g3 = bfhi(gw.y);
    float4 sgv = *(const float4*)(sg + dv);
    *(uint2*)(mixed + (size_t)tok * 1024 + h * 128 + dv) =
        pk4(o1[mt][0] * rinv * sgv.x * silu(g0), o1[mt][1] * rinv * sgv.y * silu(g1), o1[mt][2] * rinv * sgv.z * silu(g2), o1[mt][3] * rinv * sgv.w * silu(g3));
  }
}

DI void cvt8_store(float* dst, uint4 v) {
  *(float4*)dst = make_float4(bflo(v.x), bfhi(v.x), bflo(v.y), bfhi(v.y));
  *(float4*)(dst + 4) = make_float4(bflo(v.z), bfhi(v.z), bflo(v.w), bfhi(v.w));
}

DI void rwkv_scan(const P& p, int item, char* smem, unsigned* flag, unsigned tag, int TIDX) {
  const int tid = TIDX, lane = tid & 63, wave = tid >> 6;
  const int l16 = lane & 15, rsub = lane >> 4;
  const int bh = item >> 2, qd = item & 3;
  const int b = bh / 6, h = bh - b * 6;
  const int row = qd * 16 + wave * 4 + rsub;
  constexpr int NS = 16;
  constexpr int SLOT = NS * 64;
  constexpr int BUFSZ = 6 * SLOT + 16;
  float* buf = (float*)smem;
  const u16* arrR = (const u16*)(p.ws + OFF_RW_R);
  const u16* arrK = (const u16*)(p.ws + OFF_RW_K);
  const u16* arrV = (const u16*)(p.ws + OFF_RW_V);
  const u16* arrN = (const u16*)(p.ws + OFF_RW_KK);
  const u16* arrB = (const u16*)(p.ws + OFF_RW_BV);
  const float* RW = (const float*)(p.ws + OFF_RW_W);
  const float* RC = (const float*)(p.ws + OFF_RW_C) + (size_t)(b * SEQ + (tid & 15)) * 8 + h;
  u16* yraw = (u16*)(p.ws + OFF_YRAW);
  const int hi = tid >> 7, cidx = tid & 127;
  const int bst = cidx >> 3, bc8 = (cidx & 7) * 8;
  const size_t boff = (size_t)(b * SEQ + bst) * 384 + h * 64 + bc8;
  const u16* s1 = (hi ? arrK : arrR) + boff;
  const u16* s2 = (hi ? arrN : arrV) + boff;
  const int wch3 = cidx, wch4 = 128 + cidx;
  const char* s3 = hi ? (const char*)(RW + (size_t)(b * SEQ + (wch3 >> 4)) * 384 + h * 64 + (wch3 & 15) * 4) : (const char*)(arrB + boff);
  const size_t st3 = hi ? (size_t)NS * 384 * 4 : (size_t)NS * 384 * 2;
  const char* s4 = (const char*)(RW + (size_t)(b * SEQ + (wch4 >> 4)) * 384 + h * 64 + (wch4 & 15) * 4);
  const size_t st4 = (size_t)NS * 384 * 4;
  constexpr int RD = 4;
  u32x4 g1[RD], g2[RD], g3[RD], g4[RD];
  float gc[RD];
#pragma unroll
  for (int k = 0; k < RD; ++k) {
    g1[k] = *(const u32x4*)(s1 + (size_t)k * NS * 384);
    g2[k] = *(const u32x4*)(s2 + (size_t)k * NS * 384);
    g3[k] = *(const u32x4*)(s3 + (size_t)k * st3);
    g4[k] = *(const u32x4*)(s4 + (size_t)k * st4);
    gc[k] = RC[(size_t)k * NS * 8];
  }
  f32x2 Slo = {0.f, 0.f}, Shi = {0.f, 0.f};
  float yv = 0.f, sa = 0.f;
  __builtin_amdgcn_s_setprio(3);
  __syncthreads();
  for (int bt2 = 0; bt2 < SEQ / NS; bt2 += RD) {
#pragma unroll
    for (int k = 0; k < RD; ++k) {
      const int bt = bt2 + k;
      float* cb = buf + (k & 1) * BUFSZ;
      cvt8_store(cb + (hi + 0) * SLOT + bst * 64 + bc8, make_uint4(g1[k][0], g1[k][1], g1[k][2], g1[k][3]));
      cvt8_store(cb + (hi + 2) * SLOT + bst * 64 + bc8, make_uint4(g2[k][0], g2[k][1], g2[k][2], g2[k][3]));
      if (hi) *(u32x4*)(cb + 5 * SLOT + (wch3 >> 4) * 64 + (wch3 & 15) * 4) = g3[k];
      else {
        cvt8_store(cb + 4 * SLOT + bst * 64 + bc8, make_uint4(g3[k][0], g3[k][1], g3[k][2], g3[k][3]));
        *(u32x4*)(cb + 5 * SLOT + (wch4 >> 4) * 64 + (wch4 & 15) * 4) = g4[k];
      }
      if (tid < NS) cb[6 * SLOT + tid] = gc[k];
      __syncthreads();
      if (k == 0 && bt + RD == RWKV_TQ / NS) {
        if (tid == 0) {
          while (__hip_atomic_load(flag, __ATOMIC_RELAXED, __HIP_MEMORY_SCOPE_AGENT) < tag) __builtin_amdgcn_s_sleep(8);
          __builtin_amdgcn_fence(__ATOMIC_ACQUIRE, "agent");
          asm volatile("s_waitcnt vmcnt(0)" ::: "memory");
        }
        __syncthreads();
      }
      {
        const int nb = (bt + RD < SEQ / NS) ? bt + RD : SEQ / NS - 1;
        g1[k] = *(const u32x4*)(s1 + (size_t)nb * NS * 384);
        g2[k] = *(const u32x4*)(s2 + (size_t)nb * NS * 384);
        g3[k] = *(const u32x4*)(s3 + (size_t)nb * st3);
        g4[k] = *(const u32x4*)(s4 + (size_t)nb * st4);
        gc[k] = RC[(size_t)nb * NS * 8];
      }
      constexpr int PD = 2;
      f32x4 qr[PD], qk[PD], qn[PD], qb[PD], qw[PD];
      float qv[PD], qc[PD];
#pragma unroll
      for (int d = 0; d < PD; ++d) {
        qr[d] = *(const f32x4*)(cb + 0 * SLOT + d * 64 + l16 * 4);
        qk[d] = *(const f32x4*)(cb + 1 * SLOT + d * 64 + l16 * 4);
        qv[d] = cb[2 * SLOT + d * 64 + row];
        qn[d] = *(const f32x4*)(cb + 3 * SLOT + d * 64 + l16 * 4);
        qb[d] = *(const f32x4*)(cb + 4 * SLOT + d * 64 + l16 * 4);
        qw[d] = *(const f32x4*)(cb + 5 * SLOT + d * 64 + l16 * 4);
        qc[d] = cb[6 * SLOT + d];
      }
#pragma unroll
      for (int s = 0; s < NS; ++s) {
        const f32x4 r4 = qr[s % PD], k4 = qk[s % PD], n4 = qn[s % PD], b4 = qb[s % PD], w4 = qw[s % PD];
        const float vv = qv[s % PD], cc = qc[s % PD];
        if (s + PD < NS) {
          qr[s % PD] = *(const f32x4*)(cb + 0 * SLOT + (s + PD) * 64 + l16 * 4);
          qk[s % PD] = *(const f32x4*)(cb + 1 * SLOT + (s + PD) * 64 + l16 * 4);
          qv[s % PD] = cb[2 * SLOT + (s + PD) * 64 + row];
          qn[s % PD] = *(const f32x4*)(cb + 3 * SLOT + (s + PD) * 64 + l16 * 4);
          qb[s % PD] = *(const f32x4*)(cb + 4 * SLOT + (s + PD) * 64 + l16 * 4);
          qw[s % PD] = *(const f32x4*)(cb + 5 * SLOT + (s + PD) * 64 + l16 * 4);
          qc[s % PD] = cb[6 * SLOT + s + PD];
        }
        const f32x2 vv2 = {vv, vv};
        const f32x2 sa2 = {sa, sa};
        const f32x2 Tlo = Slo * w4.xy + vv2 * k4.xy;
        const f32x2 Thi = Shi * w4.zw + vv2 * k4.zw;
        Slo = Tlo + sa2 * b4.xy;
        Shi = Thi + sa2 * b4.zw;
        const f32x2 tu = Tlo * n4.xy + Thi * n4.zw;
        const f32x2 ty = Slo * r4.xy + Shi * r4.zw;
        float pu = tu.x + tu.y;
        float py = ty.x + ty.y;
        allred16_2(pu, py);
        sa = -(pu + sa * cc);
        if (l16 == s) yv = py;
        __builtin_amdgcn_sched_barrier(0);
      }
      {
        const int tok = b * SEQ + bt * NS + l16;
        yraw[(size_t)tok * 384 + h * 64 + row] = f2bf(yv);
      }
    }
  }
  __builtin_amdgcn_s_setprio(0);
}

DI void hgrn_scan(const P& p, int layer, int item, char* smem, int TIDX) {
  const int tid = TIDX, lane = tid & 63, wave = tid >> 6;
  const int l16 = lane & 15, rsub = lane >> 4;
  const int bh = item >> 2, qd = item & 3;
  const int b = bh >> 2, h = bh & 3;
  const int col = qd * 16 + wave * 4 + rsub;
  constexpr int NS = 32, SLOT = NS * 64, BUFSZ = 3 * SLOT, RD = 4;
  float* buf = (float*)smem;
  const u16* proj = (const u16*)(p.ws + OFF_PROJ);
  const float* HF = (const float*)(p.ws + OFF_HF);
  u16* mixed = (u16*)(p.ws + OFF_HBUF);
  const int ast = tid >> 3, ac8 = (tid & 7) * 8;
  const u16* sq_ = proj + (size_t)(b * SEQ + ast) * NP_ODD + 512 + h * 64 + ac8;
  const u16* sv_ = proj + (size_t)(b * SEQ + ast) * NP_ODD + 1024 + h * 64 + ac8;
  const int fst = tid >> 4, fc4 = (tid & 15) * 4;
  const float* sf_ = HF + (size_t)(b * SEQ + fst) * 256 + h * 64 + fc4;
  u32x4 gq[RD], gv[RD], gf0[RD], gf1[RD];
#pragma unroll
  for (int k = 0; k < RD; ++k) {
    gq[k] = *(const u32x4*)(sq_ + (size_t)k * NS * NP_ODD);
    gv[k] = *(const u32x4*)(sv_ + (size_t)k * NS * NP_ODD);
    gf0[k] = *(const u32x4*)(sf_ + (size_t)k * NS * 256);
    gf1[k] = *(const u32x4*)(sf_ + (size_t)(k * NS + 16) * 256);
  }
  f32x2 Slo = {0.f, 0.f}, Shi = {0.f, 0.f};
  float yv = 0.f;
  __builtin_amdgcn_s_setprio(3);
  __syncthreads();
  for (int bt4 = 0; bt4 < SEQ / NS; bt4 += RD) {
#pragma unroll
    for (int k = 0; k < RD; ++k) {
      const int bt = bt4 + k;
      float* cb = buf + (k & 1) * BUFSZ;
      cvt8_store(cb + 0 * SLOT + ast * 64 + ac8, make_uint4(gq[k][0], gq[k][1], gq[k][2], gq[k][3]));
      cvt8_store(cb + 1 * SLOT + ast * 64 + ac8, make_uint4(gv[k][0], gv[k][1], gv[k][2], gv[k][3]));
      *(u32x4*)(cb + 2 * SLOT + fst * 64 + fc4) = gf0[k];
      *(u32x4*)(cb + 2 * SLOT + (fst + 16) * 64 + fc4) = gf1[k];
      __syncthreads();
      {
        const int nb = (bt + RD < SEQ / NS) ? bt + RD : SEQ / NS - 1;
        gq[k] = *(const u32x4*)(sq_ + (size_t)nb * NS * NP_ODD);
        gv[k] = *(const u32x4*)(sv_ + (size_t)nb * NS * NP_ODD);
        gf0[k] = *(const u32x4*)(sf_ + (size_t)nb * NS * 256);
        gf1[k] = *(const u32x4*)(sf_ + (size_t)(nb * NS + 16) * 256);
      }
      constexpr int PD = 2;
      f32x4 qq[PD], qf[PD];
      float qv[PD];
#pragma unroll
      for (int d = 0; d < PD; ++d) {
        qq[d] = *(const f32x4*)(cb + 0 * SLOT + d * 64 + l16 * 4);
        qf[d] = *(const f32x4*)(cb + 2 * SLOT + d * 64 + l16 * 4);
        qv[d] = cb[1 * SLOT + d * 64 + col];
      }
#pragma unroll
      for (int oct = 0; oct < NS / 8; ++oct) {
        float pp[8];
#pragma unroll
        for (int s8 = 0; s8 < 8; ++s8) {
          const int s = oct * 8 + s8;
          const f32x4 q4 = qq[s % PD], f4 = qf[s % PD];
          const float vv = qv[s % PD];
          if (s + PD < NS) {
            qq[s % PD] = *(const f32x4*)(cb + 0 * SLOT + (s + PD) * 64 + l16 * 4);
            qf[s % PD] = *(const f32x4*)(cb + 2 * SLOT + (s + PD) * 64 + l16 * 4);
            qv[s % PD] = cb[1 * SLOT + (s + PD) * 64 + col];
          }
          const f32x2 vv2 = {vv, vv};
          Slo = f4.xy * (Slo - vv2) + vv2;
          Shi = f4.zw * (Shi - vv2) + vv2;
          const f32x2 tq = Slo * q4.xy + Shi * q4.zw;
          pp[s8] = tq.x + tq.y;
          __builtin_amdgcn_sched_barrier(0);
        }
#pragma unroll
        for (int s8 = 0; s8 < 8; ++s8) pp[s8] += dppf<0x128>(pp[s8]);
#pragma unroll
        for (int s8 = 0; s8 < 8; ++s8) pp[s8] += dppf<0x124>(pp[s8]);
#pragma unroll
        for (int s8 = 0; s8 < 8; ++s8) pp[s8] += dppf<0x122>(pp[s8]);
#pragma unroll
        for (int s8 = 0; s8 < 8; ++s8) pp[s8] += dppf<0x121>(pp[s8]);
#pragma unroll
        for (int s8 = 0; s8 < 8; ++s8) if (l16 == s8 + 8 * (oct & 1)) yv = pp[s8];
        if (oct & 1) {
          const int tok = b * SEQ + bt * NS + (oct >> 1) * 16 + l16;
          mixed[(size_t)tok * 1024 + 512 + h * 64 + col] = f2bf(yv);
        }
      }
    }
  }
  __builtin_amdgcn_s_setprio(0);
}

DI void phase_mix(const P& p, int layer, char* smem, int ctr_idx, int is_partner, int TIDX) {
  const int tid = TIDX;
  constexpr int NSCAN = 32;
  if ((int)blockIdx.x >= NSCAN && is_partner) return;
  if ((int)blockIdx.x < NSCAN) {
    hgrn_scan(p, layer, (int)blockIdx.x, smem, TIDX);
    asm volatile("" : "+v"(TIDX));
  }
  __shared__ int s_item;
  int* ctr = (int*)(p.ws + OFF_CTR) + ctr_idx;
  AttnSmem* sm = (AttnSmem*)smem;
  const int n_att = 1024;
  const int n_total = n_att + 1024;
  while (true) {
    __syncthreads();
    if (tid == 0) s_item = atomicAdd(ctr, 1);
    __syncthreads();
    const int item = s_item;
    if (item >= n_total) break;
    asm volatile("" : "+v"(TIDX));
    if (item < n_att) diff_tile(p, layer, item, sm, TIDX);
    else mem_tile(p, layer, item - n_att, sm, TIDX);
  }
}

DI void worker_barrier(unsigned* ctr, unsigned target) {
  asm volatile("s_waitcnt vmcnt(0)" ::: "memory");
  __syncthreads();
  if (threadIdx.x == 0) {
    __builtin_amdgcn_fence(__ATOMIC_RELEASE, "agent");
    asm volatile("s_waitcnt vmcnt(0)" ::: "memory");
    __hip_atomic_fetch_add(ctr, 1u, __ATOMIC_RELAXED, __HIP_MEMORY_SCOPE_AGENT);
    while (__hip_atomic_load(ctr, __ATOMIC_RELAXED, __HIP_MEMORY_SCOPE_AGENT) < target) __builtin_amdgcn_s_sleep(2);
    __builtin_amdgcn_fence(__ATOMIC_ACQUIRE, "agent");
    asm volatile("s_waitcnt vmcnt(0)" ::: "memory");
  }
  __syncthreads();
}

DI void phase_mix_even_split(const P& p, int layer, char* smem, int ctr_idx, int is_partner, int widx, int TIDX) {
  constexpr int NSCAN = 48;
  if ((int)blockIdx.x < NSCAN) {
    rwkv_scan(p, (int)blockIdx.x, smem, (unsigned*)(p.ws + OFF_CTR) + 44, (unsigned)layer + 1u, TIDX);
    return;
  }
  if (is_partner) return;
  const int nwa = (int)__hip_atomic_load((unsigned*)(p.ws + OFF_CTR) + 48, __ATOMIC_RELAXED, __HIP_MEMORY_SCOPE_AGENT);
  unsigned* wctr = (unsigned*)(p.ws + OFF_CTR) + 40;
  const unsigned nw = (unsigned)nwa;
  const unsigned base = (unsigned)(layer >> 1) * 3u;
  phase_prep_even(p, layer, smem, 2, widx, nwa, TIDX);
  worker_barrier(wctr, nw * (base + 1u));
  if (widx == 0 && threadIdx.x == 0) {
    __builtin_amdgcn_fence(__ATOMIC_RELEASE, "agent");
    __hip_atomic_store((unsigned*)(p.ws + OFF_CTR) + 44, (unsigned)layer + 1u, __ATOMIC_RELAXED, __HIP_MEMORY_SCOPE_AGENT);
  }
  asm volatile("" : "+v"(TIDX));
  phase_gemm_in(p, layer, smem, 2, widx, nwa, TIDX);
  worker_barrier(wctr, nw * (base + 2u));
  asm volatile("" : "+v"(TIDX));
  phase_prep_even(p, layer, smem, 1, widx, nwa, TIDX);
  worker_barrier(wctr, nw * (base + 3u));
  asm volatile("" : "+v"(TIDX));
  __shared__ int s_item2;
  int* ctr = (int*)(p.ws + OFF_CTR) + ctr_idx;
  AttnSmem* sm = (AttnSmem*)smem;
  const int n_total = 1536 + 1024;
  while (true) {
    __syncthreads();
    if (TIDX == 0) s_item2 = atomicAdd(ctr, 1);
    __syncthreads();
    const int item = s_item2;
    if (item >= n_total) break;
    asm volatile("" : "+v"(TIDX));
    if (item < 1536) moba_tile(p, layer, item, sm, TIDX);
    else mem_tile(p, layer, item - 1536, sm, TIDX);
  }
}

DI void phase_finish(const P& p, int layer, int TIDX) {
  const int tid = TIDX, lane = tid & 63, wave = tid >> 6;
  const int l16 = lane & 15, sub = lane >> 4;
  const int par = layer & 1, j = layer >> 1;
  const u16* proj = (const u16*)(p.ws + OFF_PROJ);
  u16* mixed = (u16*)(p.ws + OFF_HBUF);
  const int nw = gridDim.x * 4;
  if (!par) {
    const u16* RR = (const u16*)(p.ws + OFF_RW_R); const u16* RK = (const u16*)(p.ws + OFF_RW_K); const u16* RV = (const u16*)(p.ws + OFF_RW_V);
    const u16* YR = (const u16*)(p.ws + OFF_YRAW);
    for (int it4 = blockIdx.x * 4 + wave; it4 < NTOK * 6 / 4; it4 += nw) {
      const int it = it4 * 4 + sub;
      const int tok = it / 6, hd = it - tok * 6;
      const int ch = hd * 64 + l16 * 4;
      const size_t o = (size_t)tok * 384 + ch;
      const uint2 yw = *(const uint2*)(YR + o), rw = *(const uint2*)(RR + o), kw = *(const uint2*)(RK + o), vw = *(const uint2*)(RV + o);
      const uint2 gw = *(const uint2*)(proj + (size_t)tok * NP_EVEN + 1600 + ch);
      const float4 lg = *(const float4*)(p.in[19] + j * 384 + ch);
      const float4 lb = *(const float4*)(p.in[20] + j * 384 + ch);
      const float4 rc = *(const float4*)(p.in[18] + j * 384 + ch);
      const float y0 = bflo(yw.x), y1 = bfhi(yw.x), y2 = bflo(yw.y), y3 = bfhi(yw.y);
      const float mean = allred16((y0 + y1) + (y2 + y3)) * (1.f / 64.f);
      const float d0 = y0 - mean, d1 = y1 - mean, d2 = y2 - mean, d3 = y3 - mean;
      const float var = allred16((d0 * d0 + d1 * d1) + (d2 * d2 + d3 * d3)) * (1.f / 64.f);
      const float rs = rsqrtf(var + 64e-5f);
      const float rk = allred16((bflo(rw.x) * bflo(kw.x) * rc.x + bfhi(rw.x) * bfhi(kw.x) * rc.y) +
                                (bflo(rw.y) * bflo(kw.y) * rc.z + bfhi(rw.y) * bfhi(kw.y) * rc.w));
      const float o0 = (d0 * rs * lg.x + lb.x + rk * bflo(vw.x)) * silu(bflo(gw.x));
      const float o1 = (d1 * rs * lg.y + lb.y + rk * bfhi(vw.x)) * silu(bfhi(gw.x));
      const float o2 = (d2 * rs * lg.z + lb.z + rk * bflo(vw.y)) * silu(bflo(gw.y));
      const float o3 = (d3 * rs * lg.w + lb.w + rk * bfhi(vw.y)) * silu(bfhi(gw.y));
      *(uint2*)(mixed + (size_t)tok * 1024 + 384 + ch) = pk4(o0, o1, o2, o3);
    }
  } else {
    const float4 gg = *(const float4*)(p.in[31] + j * 64 + l16 * 4);
    for (int it4 = blockIdx.x * 4 + wave; it4 < NTOK * 4 / 4; it4 += nw) {
      const int it = it4 * 4 + sub;
      const int tok = it >> 2, hd = it & 3;
      const int ch = hd * 64 + l16 * 4;
      u16* mp = mixed + (size_t)tok * 1024 + 512 + ch;
      const uint2 yw = *(const uint2*)mp;
      const uint2 gw = *(const uint2*)(proj + (size_t)tok * NP_ODD + 1280 + ch);
      const float y0 = bflo(yw.x), y1 = bfhi(yw.x), y2 = bflo(yw.y), y3 = bfhi(yw.y);
      const float ms = allred16((y0 * y0 + y1 * y1) + (y2 * y2 + y3 * y3)) * (1.f / 64.f);
      const float rs = rsqrtf(ms + 1e-6f);
      *(uint2*)mp = pk4(y0 * rs * gg.x * silu(bflo(gw.x)), y1 * rs * gg.y * silu(bfhi(gw.x)),
                        y2 * rs * gg.z * silu(bflo(gw.y)), y3 * rs * gg.w * silu(bfhi(gw.y)));
    }
  }
}

#define XB_TMO      128
#define XB_XCNT(j)  (256  + 64 * (j))
#define XB_XSUB(j)  (1280 + 64 * (j))
#define XB_XGEN(j)  (2304 + 64 * (j))
#define XB_TOP      3328
#define XB_TOPGEN   3392
#define XCD_BAR_WORDS 3456
#define XB_SPIN_CAP (1u << 18)
#define LAS __attribute__((address_space(3)))

__device__ __forceinline__ unsigned xb_ld(unsigned* p)              { return __hip_atomic_load(p, __ATOMIC_RELAXED, __HIP_MEMORY_SCOPE_AGENT); }
__device__ __forceinline__ unsigned xb_add(unsigned* p, unsigned v) { return __hip_atomic_fetch_add(p, v, __ATOMIC_RELAXED, __HIP_MEMORY_SCOPE_AGENT); }
__device__ __forceinline__ unsigned xb_xcc_id() { return (unsigned)__builtin_amdgcn_s_getreg((3 << 11) | 20) & 0xFu; }
#define XB_SPIN(cond, bar) do { unsigned _sp = 0; while (cond) { __builtin_amdgcn_s_sleep(1); \
    if ((++_sp & 255u) == 0u) { if (xb_ld(&(bar)[XB_TMO])) break; if (_sp > XB_SPIN_CAP) { atomicAdd(&(bar)[XB_TMO], 1u); break; } } } } while (0)

struct XcdBarrier {
    unsigned* bar; unsigned x;
    volatile LAS unsigned* st;
};

__device__ __forceinline__ XcdBarrier xcd_barrier_post(unsigned* bar, volatile LAS unsigned* st) {
    XcdBarrier b; b.bar = bar; b.x = xb_xcc_id(); b.st = st;
    if (threadIdx.x == 0) (void)xb_add(&bar[XB_XCNT(b.x)], 1u);
    return b;
}
__device__ __forceinline__ void xcd_barrier_complete(unsigned* bar, unsigned x, unsigned& nloc, unsigned& nx) {
    const unsigned G = gridDim.x * gridDim.y * gridDim.z;
    unsigned sum, cnt, mine, sp = 0u;
    for (;;) {
        sum = 0u; cnt = 0u; mine = 0u;
#pragma unroll
        for (unsigned j = 0; j < 16; ++j) { const unsigned c = xb_ld(&bar[XB_XCNT(j)]); sum += c; cnt += (c > 0u) ? 1u : 0u; mine = (j == x) ? c : mine; }
        if (sum == G) break;
        __builtin_amdgcn_s_sleep(1);
        if ((++sp & 255u) == 0u) { if (xb_ld(&bar[XB_TMO])) break; if (sp > XB_SPIN_CAP) { atomicAdd(&bar[XB_TMO], 1u); break; } }
    }
    nloc = mine > 0u ? mine : 1u; nx = cnt > 0u ? cnt : 1u;
}

__device__ __forceinline__ void xcd_barrier(const XcdBarrier& b) {
    asm volatile("s_waitcnt vmcnt(0)" ::: "memory");
    __syncthreads();
    if (threadIdx.x == 0) {
        unsigned* bar = b.bar;
        __builtin_amdgcn_s_waitcnt(0);
        unsigned nloc = b.st[0], nx = b.st[1];
        if (nloc == 0u) { xcd_barrier_complete(bar, b.x, nloc, nx); b.st[0] = nloc; b.st[1] = nx; }
        const unsigned old = xb_add(&bar[XB_XSUB(b.x)], 1u);
        const unsigned gen = old / nloc;
        if (old + 1u == (gen + 1u) * nloc) {
            __builtin_amdgcn_fence(__ATOMIC_RELEASE, "agent");
            asm volatile("s_waitcnt vmcnt(0)" ::: "memory");
            const unsigned og = xb_add(&bar[XB_TOP], 1u);
            const unsigned tg = og / nx;
            if (og + 1u == (tg + 1u) * nx) xb_add(&bar[XB_TOPGEN], 1u);
            else XB_SPIN(xb_ld(&bar[XB_TOPGEN]) == tg, bar);
            __builtin_amdgcn_fence(__ATOMIC_ACQUIRE, "agent");
            xb_add(&bar[XB_XGEN(b.x)], 1u);
            asm volatile("s_waitcnt vmcnt(0)" ::: "memory");
        } else {
            XB_SPIN(xb_ld(&bar[XB_XGEN(b.x)]) == gen, bar);
            __builtin_amdgcn_fence(__ATOMIC_ACQUIRE, "agent");
            asm volatile("s_waitcnt vmcnt(0)" ::: "memory");
        }
    }
    __syncthreads();
}


constexpr int SMEM_BYTES = 2 * 128 * 144 * 2;
constexpr int NPHASE = 24;

template <bool COOP>
__global__ __launch_bounds__(256, 2) void mega(P p, int ph_lo, int ph_hi) {
  __shared__ __attribute__((aligned(16))) char smem[SMEM_BYTES];
  const int wave_s = __builtin_amdgcn_readfirstlane((int)(threadIdx.x >> 6));
  int nsync = 0;
  __shared__ __attribute__((aligned(16))) unsigned xb_st[4];
  __shared__ int s_cls[4];
  if (threadIdx.x < 4) { xb_st[threadIdx.x] = 0u; s_cls[threadIdx.x] = 0; }
  __syncthreads();
  XcdBarrier xb = xcd_barrier_post((unsigned*)(p.ws + OFF_BAR), (volatile LAS unsigned*)xb_st);
  const unsigned cu_key = ((((unsigned)__builtin_amdgcn_s_getreg((3 << 11) | 20) & 0xFu) << 8) |
                           (((unsigned)__builtin_amdgcn_s_getreg((7 << 11) | (8 << 6) | 4)) & 0xFFu)) + 1u;
  if (blockIdx.x < 48 && threadIdx.x == 0)
    __hip_atomic_store((unsigned*)(p.ws + OFF_BAR) + blockIdx.x, cu_key, __ATOMIC_RELAXED, __HIP_MEMORY_SCOPE_AGENT);
  for (int ph = ph_lo; ph < ph_hi; ++ph) {
    const int layer = ph / 6, sub = ph - layer * 6;
    if (sub == 2 && (layer & 1)) continue;
#ifdef ONLY_PHASE
    if (sub != ONLY_PHASE) continue;
#endif
    if (COOP && ph == 1) {
      int t = (int)threadIdx.x;
      asm volatile("" : "+v"(t));
      const unsigned cu_key2 = ((((unsigned)__builtin_amdgcn_s_getreg((3 << 11) | 20) & 0xFu) << 8) |
                                (((unsigned)__builtin_amdgcn_s_getreg((7 << 11) | (8 << 6) | 4)) & 0xFFu)) + 1u;
      if (t < 48) {
        const unsigned k = __hip_atomic_load((unsigned*)(p.ws + OFF_BAR) + t, __ATOMIC_RELAXED, __HIP_MEMORY_SCOPE_AGENT);
        if (k == cu_key2 && t != (int)blockIdx.x) { s_cls[0] = 1; if (t < 32) s_cls[1] = 1; }
      }
      __syncthreads();
      if (t == 0 && blockIdx.x >= 48 && s_cls[0] == 0)
        s_cls[2] = (int)__hip_atomic_fetch_add((unsigned*)(p.ws + OFF_CTR) + 48, 1u, __ATOMIC_RELAXED, __HIP_MEMORY_SCOPE_AGENT);
      __syncthreads();
    }
    int reps = 1;
    if (sub == PROBE_SUB && (PROBE_PAR == 2 || (layer & 1) == PROBE_PAR)) reps = 2;
    for (int rep = 0; rep < reps; ++rep) {
      if (COOP) { if (rep) { xcd_barrier(xb); ++nsync; } }
      int TIDX = wave_s * 64 + (int)__builtin_amdgcn_mbcnt_hi(~0u, __builtin_amdgcn_mbcnt_lo(~0u, 0u));
      asm volatile("" : "+v"(TIDX));
      int layer_l = layer;
      asm volatile("" : "+s"(layer_l));
      switch (sub) {
        case 0: phase_norm(p, layer_l, smem, TIDX); break;
        case 1: phase_gemm_in(p, layer_l, smem, (layer_l & 1) ? 0 : 1, 0, 0, TIDX); break;
        case 2: phase_prep_even(p, layer_l, smem, 0, 0, 0, TIDX); break;
        case 3:
          if (layer_l & 1) phase_mix(p, layer_l, smem, layer_l + 8 * rep, s_cls[1], TIDX);
          else phase_mix_even_split(p, layer_l, smem, layer_l + 8 * rep, s_cls[0], s_cls[2], TIDX);
          break;
        case 4: phase_finish(p, layer_l, TIDX); break;
        default: phase_gemm_out(p, layer_l, smem, TIDX); break;
      }
    }
    if (COOP) {
      if (ph + 1 < ph_hi) {
        if (ph_lo < 0) cg::this_grid().sync();
        xcd_barrier(xb);
        ++nsync;
      }
    }
  }
}

extern "C" void kernel_launch(void* const* d_in, const int* in_sizes, int n_in, void* d_out, int out_size, void* d_ws, size_t ws_size,
                              hipStream_t stream) {
  P p{};
  for (int i = 0; i < 32; ++i) p.in[i] = (const float*)d_in[i];
  p.out = (float*)d_out;
  p.ws = (char*)d_ws;
  if (ws_size < WS_NEEDED) fprintf(stderr, "workspace too small: %zu < %zu\n", ws_size, (size_t)WS_NEEDED);
  hipMemsetAsync((char*)d_ws + OFF_CTR, 0, 256, stream);
  hipMemsetAsync((char*)d_ws + OFF_BAR, 0, 16384, stream);
#if ONE_LAUNCH
  static int grid_blocks = 0;
  if (!grid_blocks) {
    int dev = 0, cus = 0, per_cu = 0;
    hipGetDevice(&dev);
    hipDeviceGetAttribute(&cus, hipDeviceAttributeMultiprocessorCount, dev);
    hipOccupancyMaxActiveBlocksPerMultiprocessor(&per_cu, mega<true>, 256, 0);
    if (per_cu > 2) per_cu = 2;
    grid_blocks = cus * per_cu;
  }
  int lo = 0, hi = NPHASE;
  void* args[] = {&p, &lo, &hi};
  hipError_t e = hipLaunchCooperativeKernel((void*)mega<true>, dim3(grid_blocks), dim3(256), args, 0, stream);
  if (e != hipSuccess) fprintf(stderr, "cooperative launch failed: %s (grid %d)\n", hipGetErrorString(e), grid_blocks);
#else
  for (int ph = 0; ph < NPHASE; ++ph) {
    if ((ph % 6) == 2 && ((ph / 6) & 1)) continue;
    mega<false><<<512, 256, 0, stream>>>(p, ph, ph + 1);
  }
#endif
}
```

```cpp
#include <hip/hip_runtime.h>
#include <hip/hip_cooperative_groups.h>
#include <stdint.h>
#include <stdio.h>
namespace cg = cooperative_groups;

#define PROBE_SUB -1
#define PROBE_PAR 2
#ifndef ONE_LAUNCH
#define ONE_LAUNCH 1
#endif

typedef __attribute__((ext_vector_type(8))) short bf16x8;
typedef __attribute__((ext_vector_type(4))) float f32x4;
typedef __attribute__((ext_vector_type(2))) float f32x2;
typedef __attribute__((ext_vector_type(2))) __bf16 bf16x2_t;
typedef unsigned short u16;
typedef __attribute__((ext_vector_type(4))) unsigned u32x4;
#define DI __device__ __forceinline__

constexpr int DM = 1024, SEQ = 8192, NTOK = 16384;
constexpr int NP_EVEN = 2240, NP_ODD = 1792;
constexpr int RWKV_TQ = 2048;
constexpr int LS = 80;
constexpr int LSG = 144;

constexpr size_t OFF_WT_IN = 0;
constexpr size_t OFF_WT_OUT = OFF_WT_IN + (size_t)3648 * 1024 * 2;
constexpr size_t OFF_WT_KV = OFF_WT_OUT + (size_t)1024 * 1024 * 2;
constexpr size_t OFF_COS = OFF_WT_KV + (size_t)512 * 1024 * 2;
constexpr size_t OFF_SIN = OFF_COS + (size_t)SEQ * 8 * 4;
constexpr size_t OFF_HBUF = OFF_SIN + (size_t)SEQ * 8 * 4;
constexpr size_t OFF_MEMH = OFF_HBUF + (size_t)NTOK * 1024 * 2;
constexpr size_t OFF_KM = OFF_MEMH + (size_t)512 * 1024 * 2;
constexpr size_t OFF_VMT = OFF_KM + (size_t)2 * 4 * 256 * 64 * 2;
constexpr size_t OFF_PROJ = OFF_VMT + (size_t)2 * 256 * 256 * 2;
constexpr size_t OFF_QM = OFF_PROJ + (size_t)NTOK * NP_EVEN * 2;
constexpr size_t OFF_KMEAN = OFF_QM + (size_t)NTOK * 256 * 2;
constexpr size_t OFF_CTR = OFF_KMEAN + (size_t)2 * 6 * 32 * 64 * 4;
constexpr size_t OFF_X = OFF_CTR + 256;
constexpr size_t SZ_QE = (size_t)NTOK * 384 * 2;
constexpr size_t OFF_Q1E = OFF_X, OFF_K1E = OFF_Q1E + SZ_QE, OFF_VTE = OFF_K1E + SZ_QE;
constexpr size_t OFF_RW_R = OFF_VTE + SZ_QE, OFF_RW_K = OFF_RW_R + SZ_QE, OFF_RW_V = OFF_RW_K + SZ_QE,
                 OFF_RW_KK = OFF_RW_V + SZ_QE, OFF_RW_BV = OFF_RW_KK + SZ_QE, OFF_RW_W = OFF_RW_BV + SZ_QE;
constexpr size_t END_EVEN = OFF_RW_W + (size_t)NTOK * 384 * 4;
constexpr size_t SZ_QO = (size_t)NTOK * 512 * 2;
constexpr size_t OFF_Q1O = OFF_X, OFF_K1O = OFF_Q1O + SZ_QO, OFF_VTO = OFF_K1O + SZ_QO;
constexpr size_t OFF_HF = OFF_VTO + SZ_QO;
constexpr size_t OFF_RW_C = END_EVEN;
constexpr size_t OFF_BAR = OFF_RW_C + (size_t)NTOK * 8 * 4;
constexpr size_t OFF_CTR2 = OFF_BAR + 16384;
constexpr size_t OFF_YRAW = OFF_CTR2 + 256;
constexpr size_t WS_NEEDED = OFF_YRAW + (size_t)NTOK * 384 * 2;
static_assert(OFF_HF + (size_t)NTOK * 256 * 4 <= END_EVEN, "odd-layer scratch overflows union region");

struct P {
  const float* in[32];
  float* out;
  char* ws;
};

DI u16 f2bf(float x) { uint32_t u = __float_as_uint(x); u += 0x7fffu + ((u >> 16) & 1u); return (u16)(u >> 16); }
DI float bf2f(u16 v) { return __uint_as_float(((uint32_t)v) << 16); }
DI uint32_t pk2(float a, float b) { f32x2 v = {a, b}; bf16x2_t r = __builtin_convertvector(v, bf16x2_t); return __builtin_bit_cast(uint32_t, r); }
DI uint2 pk4(float a, float b, float c, float d) { return make_uint2(pk2(a, b), pk2(c, d)); }
DI float bflo(uint32_t w) { return __uint_as_float(w << 16); }
DI float bfhi(uint32_t w) { return __uint_as_float(w & 0xffff0000u); }
DI float silu(float g) { return g * __builtin_amdgcn_rcpf(1.f + __expf(-g)); }
DI float sigm(float g) { return __builtin_amdgcn_rcpf(1.f + __expf(-g)); }
template <int CTRL> DI float dppf0(float x) {
  return __builtin_bit_cast(float, __builtin_amdgcn_update_dpp(0, __builtin_bit_cast(int, x), CTRL, 0xF, 0xF, false));
}
DI float wsum(float x) {
  x += dppf0<0x128>(x); x += dppf0<0x124>(x); x += dppf0<0x122>(x); x += dppf0<0x121>(x);
  const float s0 = __builtin_bit_cast(float, __builtin_amdgcn_readlane(__builtin_bit_cast(int, x), 0));
  const float s1 = __builtin_bit_cast(float, __builtin_amdgcn_readlane(__builtin_bit_cast(int, x), 16));
  const float s2 = __builtin_bit_cast(float, __builtin_amdgcn_readlane(__builtin_bit_cast(int, x), 32));
  const float s3 = __builtin_bit_cast(float, __builtin_amdgcn_readlane(__builtin_bit_cast(int, x), 48));
  return (s0 + s1) + (s2 + s3);
}
template <int CTRL> DI float dppf(float x) {
  return __builtin_bit_cast(float, __builtin_amdgcn_update_dpp(0, __builtin_bit_cast(int, x), CTRL, 0xF, 0xF, false));
}
DI float allred16(float x) {
  x += dppf<0x128>(x); x += dppf<0x124>(x); x += dppf<0x122>(x); x += dppf<0x121>(x);
  return x;
}
DI void allred16_2(float& x, float& y) {
  x += dppf<0x128>(x); y += dppf<0x128>(y);
  x += dppf<0x124>(x); y += dppf<0x124>(y);
  x += dppf<0x122>(x); y += dppf<0x122>(y);
  x += dppf<0x121>(x); y += dppf<0x121>(y);
}
#define MFMA16(a, b, c) __builtin_amdgcn_mfma_f32_16x16x32_bf16((a), (b), (c), 0, 0, 0)

DI void transpose_w(const float* __restrict__ W, int N, u16* __restrict__ Wt, int tile, float* tl, int TIDX) {
  const int tid = TIDX;
  const int kt = tile & 15, nt = tile >> 4;
  const int k0 = kt * 64, n0 = nt * 64;
  __syncthreads();
  {
    const int r = tid >> 4, c4 = tid & 15;
#pragma unroll
    for (int rr = 0; rr < 4; ++rr) {
      int k = rr * 16 + r;
      float4 v = *(const float4*)(W + (size_t)(k0 + k) * N + n0 + c4 * 4);
      tl[k * 65 + c4 * 4 + 0] = v.x; tl[k * 65 + c4 * 4 + 1] = v.y; tl[k * 65 + c4 * 4 + 2] = v.z; tl[k * 65 + c4 * 4 + 3] = v.w;
    }
  }
  __syncthreads();
  {
    const int n = tid >> 2, kq = tid & 3;
    uint32_t w[8];
#pragma unroll
    for (int i = 0; i < 8; ++i) w[i] = pk2(tl[(kq * 16 + 2 * i) * 65 + n], tl[(kq * 16 + 2 * i + 1) * 65 + n]);
    uint4* dst = (uint4*)(Wt + (size_t)(n0 + n) * 1024 + k0 + kq * 16);
    dst[0] = make_uint4(w[0], w[1], w[2], w[3]);
    dst[1] = make_uint4(w[4], w[5], w[6], w[7]);
  }
}

DI void phase_norm(const P& p, int layer, char* smem, int TIDX) {
  const int tid = TIDX, lane = tid & 63, wave = tid >> 6;
  const int par = layer & 1, j = layer >> 1;
  const float* xin = (layer == 0) ? p.in[0] : p.out;
  u16* hbuf = (u16*)(p.ws + OFF_HBUF);
  u16* memh = (u16*)(p.ws + OFF_MEMH);
  const float* g1 = p.in[2] + layer * 1024;
  const float* g2 = p.in[3] + layer * 1024;
  const int nw = gridDim.x * 4;
  for (int row = blockIdx.x * 4 + wave; row < NTOK + 512; row += nw) {
    const float* src = row < NTOK ? xin + (size_t)row * 1024 : p.in[1] + (size_t)(row - NTOK) * 1024;
    const float* g = row < NTOK ? g1 : g2;
    u16* dst = row < NTOK ? hbuf + (size_t)row * 1024 : memh + (size_t)(row - NTOK) * 1024;
    float4 v[4];
    float ss = 0.f;
#pragma unroll
    for (int q = 0; q < 4; ++q) {
      v[q] = *(const float4*)(src + q * 256 + lane * 4);
      ss += v[q].x * v[q].x + v[q].y * v[q].y + v[q].z * v[q].z + v[q].w * v[q].w;
    }
    ss = wsum(ss);
    float rinv = rsqrtf(ss * (1.f / 1024.f) + 1e-6f);
#pragma unroll
    for (int q = 0; q < 4; ++q) {
      float4 gg = *(const float4*)(g + q * 256 + lane * 4);
      *(uint2*)(dst + q * 256 + lane * 4) = pk4(v[q].x * rinv * gg.x, v[q].y * rinv * gg.y, v[q].z * rinv * gg.z, v[q].w * rinv * gg.w);
    }
  }
  const int nin = par ? 3584 : 3648;
  const float* win = par ? p.in[21] + (size_t)j * 1024 * 3584 : p.in[7] + (size_t)j * 1024 * 3648;
  const float* wout = par ? p.in[22] + (size_t)j * 1024 * 1024 : p.in[8] + (size_t)j * 1024 * 1024;
  const float* wkv = p.in[4] + (size_t)layer * 1024 * 512;
  const int t_in = (nin / 64) * 16, t_out = 16 * 16, t_kv = 8 * 16;
  for (int t = blockIdx.x; t < t_in + t_out + t_kv; t += gridDim.x) {
    if (t < t_in) transpose_w(win, nin, (u16*)(p.ws + OFF_WT_IN), t, (float*)smem, TIDX);
    else if (t < t_in + t_out) transpose_w(wout, 1024, (u16*)(p.ws + OFF_WT_OUT), t - t_in, (float*)smem, TIDX);
    else transpose_w(wkv, 512, (u16*)(p.ws + OFF_WT_KV), t - t_in - t_out, (float*)smem, TIDX);
  }
  if (layer == 0) {
    float* ct = (float*)(p.ws + OFF_COS);
    float* st = (float*)(p.ws + OFF_SIN);
    for (int e = blockIdx.x * 256 + tid; e < SEQ * 8; e += gridDim.x * 256) {
      int pos = e >> 3, i = e & 7;
      float inv = 1.0f / powf(500000.0f, (float)(2 * i) / 16.0f);
      float ang = (float)pos * inv;
      float s, c;
      sincosf(ang, &s, &c);
      ct[e] = c; st[e] = s;
    }
  }
}

DI void gemm_mainloop(const u16* __restrict__ A, int lda, int m0, const u16* __restrict__ Bt, int ldb, int n0, int N, int K,
                      u16* As, u16* Bs, f32x4 (&acc)[4][4], int TIDX) {
  const int tid = TIDX, lane = tid & 63, wave = tid >> 6;
  const int wm = wave >> 1, wn = wave & 1;
  const int r16 = lane & 15, quad = lane >> 4;
  u32x4 ra[8], rb[8];
#pragma unroll
  for (int a = 0; a < 4; ++a)
#pragma unroll
    for (int b = 0; b < 4; ++b) acc[a][b] = (f32x4){0.f, 0.f, 0.f, 0.f};
  const int srow = tid >> 4, skc = tid & 15;
#pragma unroll
  for (int jj = 0; jj < 8; ++jj) {
    int row = srow + 16 * jj;
    ra[jj] = *(const u32x4*)(A + (size_t)(m0 + row) * lda + skc * 8);
    int n = n0 + row;
    rb[jj] = (n < N) ? *(const u32x4*)(Bt + (size_t)n * ldb + skc * 8) : (u32x4){0u, 0u, 0u, 0u};
  }
  for (int k0 = 0; k0 < K; k0 += 128) {
    __syncthreads();
#pragma unroll
    for (int jj = 0; jj < 8; ++jj) {
      int row = srow + 16 * jj;
      *(u32x4*)(As + row * LSG + skc * 8) = ra[jj];
      *(u32x4*)(Bs + row * LSG + skc * 8) = rb[jj];
    }
    __syncthreads();
    if (k0 + 128 < K) {
#pragma unroll
      for (int jj = 0; jj < 8; ++jj) {
        int row = srow + 16 * jj;
        ra[jj] = *(const u32x4*)(A + (size_t)(m0 + row) * lda + k0 + 128 + skc * 8);
        int n = n0 + row;
        rb[jj] = (n < N) ? *(const u32x4*)(Bt + (size_t)n * ldb + k0 + 128 + skc * 8) : (u32x4){0u, 0u, 0u, 0u};
      }
    }
#pragma unroll
    for (int kk = 0; kk < 4; ++kk) {
      bf16x8 af[4], bfr[4];
#pragma unroll
      for (int mt = 0; mt < 4; ++mt) af[mt] = *(const bf16x8*)(As + (wm * 64 + mt * 16 + r16) * LSG + kk * 32 + quad * 8);
#pragma unroll
      for (int nt = 0; nt < 4; ++nt) bfr[nt] = *(const bf16x8*)(Bs + (wn * 64 + nt * 16 + r16) * LSG + kk * 32 + quad * 8);
#pragma unroll
      for (int mt = 0; mt < 4; ++mt)
#pragma unroll
        for (int nt = 0; nt < 4; ++nt) acc[mt][nt] = MFMA16(bfr[nt], af[mt], acc[mt][nt]);
    }
  }
}

constexpr int ELS = 72;
DI u16* epi_region(char* smem, int TIDX) { return (u16*)smem + (TIDX >> 6) * (64 * ELS); }
template <class F> DI void epi_flush_rows(const u16* W, F rowptr, int TIDX) {
  const int lane = TIDX & 63;
#pragma unroll
  for (int it = 0; it < 8; ++it) {
    const int row = it * 8 + (lane >> 3), ch = lane & 7;
    const u32x4 v = *(const u32x4*)(W + row * ELS + ch * 8);
    *(u32x4*)(rowptr(row) + ch * 8) = v;
  }
}
DI void epi_qk(f32x4 (&acc)[4][4], int rowbase, int SL, int H, int head, const float* __restrict__ gain, bool rope,
               const float* __restrict__ ct, const float* __restrict__ st, u16* __restrict__ dst, char* smem, int TIDX) {
  const int lane = TIDX & 63, r16 = lane & 15, quad = lane >> 4;
  u16* W = epi_region(smem, TIDX);
  float gv[4][4];
#pragma unroll
  for (int nt = 0; nt < 4; ++nt)
#pragma unroll
    for (int i = 0; i < 4; ++i) gv[nt][i] = gain[nt * 16 + quad * 4 + i];
#pragma unroll
  for (int mt = 0; mt < 4; ++mt) {
    const int row = rowbase + mt * 16 + r16;
    const int b = row / SL, s = row - b * SL;
    float ss = 0.f;
#pragma unroll
    for (int nt = 0; nt < 4; ++nt)
#pragma unroll
      for (int i = 0; i < 4; ++i) ss += acc[mt][nt][i] * acc[mt][nt][i];
    ss += __shfl_xor(ss, 16);
    ss += __shfl_xor(ss, 32);
    const float rinv = rsqrtf(ss * (1.f / 64.f) + 1e-6f);
#pragma unroll
    for (int nt = 0; nt < 4; ++nt) {
      float v[4];
#pragma unroll
      for (int i = 0; i < 4; ++i) v[i] = acc[mt][nt][i] * rinv * gv[nt][i];
      if (nt == 0 && rope) {
#pragma unroll
        for (int i = 0; i < 4; ++i) {
          float pr = __shfl_xor(v[i], 32);
          int idx = (quad & 1) * 4 + i;
          float c = ct[s * 8 + idx], sn = st[s * 8 + idx];
          v[i] = (quad < 2) ? (v[i] * c - pr * sn) : (pr * sn + v[i] * c);
        }
      }
      *(uint2*)(W + (mt * 16 + r16) * ELS + nt * 16 + quad * 4) = pk4(v[0], v[1], v[2], v[3]);
    }
  }
  const int b0 = rowbase / SL, s0 = rowbase - b0 * SL;
  u16* base = dst + ((size_t)(b0 * H + head) * SL + s0) * 64;
  epi_flush_rows(W, [&](int r) { return base + (size_t)r * 64; }, TIDX);
}
DI void epi_vt(f32x4 (&acc)[4][4], int rowbase, int SL, int Wd, int colbase, u16* __restrict__ dst, char* smem, int TIDX) {
  const int lane = TIDX & 63, r16 = lane & 15, quad = lane >> 4;
  u16* W = epi_region(smem, TIDX);
#pragma unroll
  for (int mt = 0; mt < 4; ++mt)
#pragma unroll
    for (int nt = 0; nt < 4; ++nt)
#pragma unroll
      for (int i = 0; i < 4; ++i) W[(nt * 16 + quad * 4 + i) * ELS + mt * 16 + r16] = f2bf(acc[mt][nt][i]);
  const int b0 = rowbase / SL, s0 = rowbase - b0 * SL;
  u16* base = dst + ((size_t)b0 * Wd + colbase) * SL + s0;
  epi_flush_rows(W, [&](int c) { return base + (size_t)c * SL; }, TIDX);
}
DI void epi_plain(f32x4 (&acc)[4][4], int rowbase, int NP, int dcol, u16* __restrict__ proj, char* smem, int TIDX) {
  const int lane = TIDX & 63, r16 = lane & 15, quad = lane >> 4;
  u16* W = epi_region(smem, TIDX);
#pragma unroll
  for (int mt = 0; mt < 4; ++mt)
#pragma unroll
    for (int nt = 0; nt < 4; ++nt)
      *(uint2*)(W + (mt * 16 + r16) * ELS + nt * 16 + quad * 4) = pk4(acc[mt][nt][0], acc[mt][nt][1], acc[mt][nt][2], acc[mt][nt][3]);
  u16* base = proj + (size_t)rowbase * NP + dcol;
  epi_flush_rows(W, [&](int r) { return base + (size_t)r * NP; }, TIDX);
}

DI void epi_fgate(f32x4 (&acc)[4][4], int rowbase, int colbase, int jodd, const float* __restrict__ dlb, float* __restrict__ dst, int TIDX) {
  const int lane = TIDX & 63, r16 = lane & 15, quad = lane >> 4;
  float lb[4][4];
#pragma unroll
  for (int nt = 0; nt < 4; ++nt)
#pragma unroll
    for (int i = 0; i < 4; ++i) {
      const int c = colbase + nt * 16 + quad * 4 + i;
      lb[nt][i] = (jodd == 1) ? fmaxf(sigm(dlb[256 + c] - dlb[c]), 0.f) : 0.f;
    }
#pragma unroll
  for (int mt = 0; mt < 4; ++mt) {
    const int row = rowbase + mt * 16 + r16;
#pragma unroll
    for (int nt = 0; nt < 4; ++nt) {
      float4 o;
      o.x = lb[nt][0] + (1.f - lb[nt][0]) * sigm(acc[mt][nt][0]);
      o.y = lb[nt][1] + (1.f - lb[nt][1]) * sigm(acc[mt][nt][1]);
      o.z = lb[nt][2] + (1.f - lb[nt][2]) * sigm(acc[mt][nt][2]);
      o.w = lb[nt][3] + (1.f - lb[nt][3]) * sigm(acc[mt][nt][3]);
      *(float4*)(dst + (size_t)row * 256 + colbase + nt * 16 + quad * 4) = o;
    }
  }
}

DI void phase_gemm_in(const P& p, int layer, char* smem, int part, int widx, int nwa, int TIDX) {
  const int par = layer & 1, j = layer >> 1;
  const int wave = TIDX >> 6, wm = wave >> 1, wn = wave & 1;
  u16* As = (u16*)smem;
  u16* Bs = As + 128 * LSG;
  const int N = par ? 3584 : 3648;
  const int NT = par ? 28 : 29;
  const int NU = par ? 56 : 57;
  const int NP = par ? NP_ODD : NP_EVEN;
  const int main_tiles = 128 * NT;
  const float* ct = (const float*)(p.ws + OFF_COS);
  const float* st = (const float*)(p.ws + OFF_SIN);
  u16* proj = (u16*)(p.ws + OFF_PROJ);
  u16* Q1 = (u16*)(p.ws + (par ? OFF_Q1O : OFF_Q1E));
  u16* K1 = (u16*)(p.ws + (par ? OFF_K1O : OFF_K1E));
  u16* VT = (u16*)(p.ws + (par ? OFF_VTO : OFF_VTE));
  u16* QM = (u16*)(p.ws + OFF_QM);
  const int nnt = (part == 0) ? NT : (part == 1 ? 10 : NT - 10);
  const int ntile = 128 * nnt + (part == 1 ? 0 : 16);
  for (int q = (part == 2) ? widx : (int)blockIdx.x; q < ntile; q += (part == 2) ? nwa : (int)gridDim.x) {
    asm volatile("" : "+v"(TIDX));
    int t, mi = 0, ni = 0;
    if (q < 128 * nnt) {
      const int grp = q / (8 * nnt), r = q - grp * (8 * nnt);
      const int nj = r >> 3;
      mi = grp * 8 + (r & 7);
      ni = (part == 0) ? nj : (part == 1 ? nj + 12 : (nj < 12 ? nj : nj + 10));
      t = 0;
    } else {
      t = main_tiles + (q - 128 * nnt);
    }
    f32x4 acc[4][4];
    if (t < main_tiles) {
      const int m0 = mi * 128, n0 = ni * 128;
      gemm_mainloop((const u16*)(p.ws + OFF_HBUF), 1024, m0, (const u16*)(p.ws + OFF_WT_IN), 1024, n0, N, 1024, As, Bs, acc, TIDX);
      const int u = (n0 >> 6) + wn;
      const int rowbase = m0 + wm * 64;
      __syncthreads();
      if (u < NU) {
        if (!par) {
          if (u < 6) epi_qk(acc, rowbase, SEQ, 6, u, p.in[9] + j * 64, true, ct, st, Q1, smem, TIDX);
          else if (u < 12) epi_qk(acc, rowbase, SEQ, 6, u - 6, p.in[10] + j * 64, true, ct, st, K1, smem, TIDX);
          else if (u < 18) epi_vt(acc, rowbase, SEQ, 384, (u - 12) * 64, VT, smem, TIDX);
          else if (u < 49) epi_plain(acc, rowbase, NP, (u - 18) * 64, proj, smem, TIDX);
          else if (u < 53) epi_qk(acc, rowbase, SEQ, 4, u - 49, p.in[5] + layer * 64, false, ct, st, QM, smem, TIDX);
          else epi_plain(acc, rowbase, NP, (u - 22) * 64, proj, smem, TIDX);
        } else {
          if (u < 8) epi_qk(acc, rowbase, SEQ, 8, u, p.in[23] + j * 64, true, ct, st, Q1, smem, TIDX);
          else if (u < 16) epi_qk(acc, rowbase, SEQ, 8, u - 8, p.in[24] + j * 64, true, ct, st, K1, smem, TIDX);
          else if (u < 24) epi_vt(acc, rowbase, SEQ, 512, (u - 16) * 64, VT, smem, TIDX);
          else if (u >= 36 && u < 40) epi_fgate(acc, rowbase, (u - 36) * 64, j, p.in[30], (float*)(p.ws + OFF_HF), TIDX);
          else if (u < 48) epi_plain(acc, rowbase, NP, (u - 24) * 64, proj, smem, TIDX);
          else if (u < 52) epi_qk(acc, rowbase, SEQ, 4, u - 48, p.in[5] + layer * 64, false, ct, st, QM, smem, TIDX);
          else epi_plain(acc, rowbase, NP, (u - 28) * 64, proj, smem, TIDX);
        }
      }
    } else {
      const int tt = t - main_tiles;
      const int mi = tt >> 2, ni = tt & 3;
      const int m0 = mi * 128, n0 = ni * 128;
      gemm_mainloop((const u16*)(p.ws + OFF_MEMH), 1024, m0, (const u16*)(p.ws + OFF_WT_KV), 1024, n0, 512, 1024, As, Bs, acc, TIDX);
      const int u = (n0 >> 6) + wn;
      const int rowbase = m0 + wm * 64;
      __syncthreads();
      if (u < 4) epi_qk(acc, rowbase, 256, 4, u, p.in[6] + layer * 64, false, ct, st, (u16*)(p.ws + OFF_KM), smem, TIDX);
      else epi_vt(acc, rowbase, 256, 256, (u - 4) * 64, (u16*)(p.ws + OFF_VMT), smem, TIDX);
    }
  }
}

DI void phase_gemm_out(const P& p, int layer, char* smem, int TIDX) {
  const int lane = TIDX & 63, wave = TIDX >> 6, wm = wave >> 1, wn = wave & 1;
  const int r16 = lane & 15, quad = lane >> 4;
  u16* As = (u16*)smem;
  u16* Bs = As + 128 * LSG;
  const float* xin = (layer == 0) ? p.in[0] : p.out;
  float* xout = p.out;
  const int xcd = blockIdx.x & 7, xlocal = blockIdx.x >> 3, xnl = gridDim.x >> 3;
  for (int idx = xlocal; idx < 2 * 64; idx += xnl) {
    f32x4 acc[4][4];
    const int sidx = (idx >> 6) * 8 + xcd, within = idx & 63;
    const int mi = sidx * 8 + (within >> 3), ni = within & 7;
    const int m0 = mi * 128, n0 = ni * 128;
    gemm_mainloop((const u16*)(p.ws + OFF_HBUF), 1024, m0, (const u16*)(p.ws + OFF_WT_OUT), 1024, n0, 1024, 1024, As, Bs, acc, TIDX);
#pragma unroll
    for (int mt = 0; mt < 4; ++mt) {
      const int row = m0 + wm * 64 + mt * 16 + r16;
#pragma unroll
      for (int nt = 0; nt < 4; ++nt) {
        const size_t o = (size_t)row * 1024 + n0 + wn * 64 + nt * 16 + quad * 4;
        float4 xv = *(const float4*)(xin + o);
        xv.x += acc[mt][nt][0]; xv.y += acc[mt][nt][1]; xv.z += acc[mt][nt][2]; xv.w += acc[mt][nt][3];
        *(float4*)(xout + o) = xv;
      }
    }
  }
}

DI void phase_prep_even(const P& p, int layer, char* smem, int mode, int widx, int nwa, int TIDX) {
  const int tid = TIDX, lane = tid & 63, wave = tid >> 6;
  const int j = layer >> 1;
  const u16* proj = (const u16*)(p.ws + OFF_PROJ);
  const int NP = NP_EVEN;
  float* lds = (float*)smem;
  const int n_rw = 256 * 6, n_km = 2 * 6 * 32;
  constexpr int GE = RWKV_TQ / 64;
  const int n_early = 2 * GE * 6, n_late = n_rw - n_early;
  const int i_lo = 0, i_hi = (mode == 0) ? n_early : (mode == 2 ? n_late : n_km);
  for (int it0 = i_lo + (mode ? widx : (int)blockIdx.x); it0 < i_hi; it0 += (mode ? nwa : (int)gridDim.x)) {
    asm volatile("" : "+v"(TIDX));
    int item;
    if (mode == 1) item = n_rw + it0;
    else {
      const int hd_ = it0 % 6, gi = it0 / 6;
      int grp_;
      if (mode == 0) grp_ = (gi / GE) * 128 + (gi % GE);
      else grp_ = (gi / (128 - GE)) * 128 + GE + (gi % (128 - GE));
      item = grp_ * 6 + hd_;
    }
    __syncthreads();
    if (item < n_rw) {
      const int grp = item / 6, hd = item - grp * 6;
      const int tok0 = grp * 64;
      const float* mu = p.in[11] + j * 1216;
#pragma unroll
      for (int q = 0; q < 16; ++q) {
        int e = tid + 256 * q;
        int tk = e >> 6, c = e & 63;
        int tok = tok0 + tk;
        float cur = bf2f(proj[(size_t)tok * NP + 1536 + c]);
        float prev = ((tok & (SEQ - 1)) == 0) ? 0.f : bf2f(proj[(size_t)(tok - 1) * NP + 1536 + c]);
        float sh = cur + (prev - cur) * mu[1152 + c];
        if (c < 32) sh = 1.f - 2.f / (__expf(2.f * sh) + 1.f);
        lds[tk * 64 + c] = sh;
      }
      __syncthreads();
      const int c = lane, tg = wave, ch = hd * 64 + c;
      float w2c[32], a2c[32];
      const float* w2 = p.in[13] + (size_t)j * 32 * 384;
      const float* a2 = p.in[15] + (size_t)j * 32 * 384;
#pragma unroll
      for (int q = 0; q < 32; ++q) { w2c[q] = w2[q * 384 + ch]; a2c[q] = a2[q * 384 + ch]; }
      const float w0c = p.in[12][j * 384 + ch], a0c = p.in[14][j * 384 + ch];
      const float kkc = p.in[16][j * 384 + ch], kac = p.in[17][j * 384 + ch];
      const float mur = mu[ch], muk = mu[384 + ch], muv = mu[768 + ch];
      int tokf = tok0 + tg * 16;
      float pr = 0.f, pk = 0.f, pv = 0.f;
      if ((tokf & (SEQ - 1)) != 0) {
        pr = bf2f(proj[(size_t)(tokf - 1) * NP + 384 + ch]);
        pk = bf2f(proj[(size_t)(tokf - 1) * NP + 768 + ch]);
        pv = bf2f(proj[(size_t)(tokf - 1) * NP + 1152 + ch]);
      }
      u16* RR = (u16*)(p.ws + OFF_RW_R); u16* RK = (u16*)(p.ws + OFF_RW_K); u16* RV = (u16*)(p.ws + OFF_RW_V);
      u16* RKK = (u16*)(p.ws + OFF_RW_KK); u16* RBV = (u16*)(p.ws + OFF_RW_BV); float* RW = (float*)(p.ws + OFF_RW_W);
      float* RC = (float*)(p.ws + OFF_RW_C);
      float ck_cur = bf2f(proj[(size_t)tokf * NP + 768 + ch]);
      float ksh_cur = ck_cur + (pk - ck_cur) * muk;
      float kkn_cur;
      {
        float kk0 = ksh_cur * kkc;
        float ssq0 = wsum(kk0 * kk0);
        kkn_cur = bf2f(f2bf(kk0 * rsqrtf(fmaxf(ssq0, 1e-24f))));
      }
      float cr_c[4], ck_c[4], cv_c[4];
#pragma unroll
      for (int i = 0; i < 4; ++i) {
        cr_c[i] = bf2f(proj[(size_t)(tokf + i) * NP + 384 + ch]);
        ck_c[i] = bf2f(proj[(size_t)(tokf + i) * NP + 768 + ch]);
        cv_c[i] = bf2f(proj[(size_t)(tokf + i) * NP + 1152 + ch]);
      }
      for (int g4 = 0; g4 < 4; ++g4) {
        float cr_n[4], ck_n4[4], cv_n[4];
#pragma unroll
        for (int i = 0; i < 4; ++i) {
          int tn = tokf + 4 * (g4 + 1) + i;
          tn = tn < NTOK ? tn : NTOK - 1;
          cr_n[i] = bf2f(proj[(size_t)tn * NP + 384 + ch]);
          ck_n4[i] = bf2f(proj[(size_t)tn * NP + 768 + ch]);
          cv_n[i] = bf2f(proj[(size_t)tn * NP + 1152 + ch]);
        }
#pragma unroll
        for (int i = 0; i < 4; ++i) {
          const int tt = g4 * 4 + i;
          const int tok = tokf + tt, tk = tg * 16 + tt;
          const float cr = cr_c[i], cv = cv_c[i];
          float r = cr + (pr - cr) * mur, v = cv + (pv - cv) * muv;
          const float k = ksh_cur;
          pr = cr; pv = cv;
          float ck_n = 0.f, ksh_n = 0.f, kkn_n = 0.f;
          if (((tok + 1) & (SEQ - 1)) != 0) {
            ck_n = (i < 3) ? ck_c[(i + 1) & 3] : ck_n4[0];
            ksh_n = ck_n + (ck_cur - ck_n) * muk;
            float kk1 = ksh_n * kkc;
            float ssq1 = wsum(kk1 * kk1);
            kkn_n = bf2f(f2bf(kk1 * rsqrtf(fmaxf(ssq1, 1e-24f))));
          }
          float dw = 0.f, da = 0.f;
#pragma unroll
          for (int q = 0; q < 8; ++q) {
            float4 l1 = *(const float4*)(lds + tk * 64 + q * 4);
            float4 l2 = *(const float4*)(lds + tk * 64 + 32 + q * 4);
            dw += l1.x * w2c[q * 4] + l1.y * w2c[q * 4 + 1] + l1.z * w2c[q * 4 + 2] + l1.w * w2c[q * 4 + 3];
            da += l2.x * a2c[q * 4] + l2.y * a2c[q * 4 + 1] + l2.z * a2c[q * 4 + 2] + l2.w * a2c[q * 4 + 3];
          }
          float win = w0c + dw;
          float z = -win;
          float sp = (z > 20.f) ? z : log1pf(__expf(z));
          float wlog = -sp - 0.5f;
          float decay = __expf(-__expf(wlog));
          float asig = sigm(a0c + da);
          float kmod = k * (1.f + (asig - 1.f) * kac);
          const float bv = bf2f(f2bf(kkn_cur * asig));
          const float cdot = wsum(bv * kkn_n);
          const size_t o = (size_t)tok * 384 + ch;
          RR[o] = f2bf(r); RK[o] = f2bf(kmod); RV[o] = f2bf(v); RKK[o] = f2bf(kkn_n); RBV[o] = f2bf(bv); RW[o] = decay;
          if (lane == 0) RC[(size_t)tok * 8 + hd] = cdot;
          ck_cur = ck_n; ksh_cur = ksh_n; kkn_cur = kkn_n;
        }
#pragma unroll
        for (int i = 0; i < 4; ++i) { cr_c[i] = cr_n[i]; ck_c[i] = ck_n4[i]; cv_c[i] = cv_n[i]; }
      }
    } else {
      const int it = item - n_rw;
      const int bh = it >> 5, blk = it & 31;
      const u16* K1 = (const u16*)(p.ws + OFF_K1E) + ((size_t)bh * SEQ + blk * 256) * 64;
      const int d8 = tid & 7, kr = tid >> 3;
      float a[8] = {0.f, 0.f, 0.f, 0.f, 0.f, 0.f, 0.f, 0.f};
#pragma unroll
      for (int q = 0; q < 8; ++q) {
        uint4 v = *(const uint4*)(K1 + (size_t)(kr * 8 + q) * 64 + d8 * 8);
        a[0] += bflo(v.x); a[1] += bfhi(v.x); a[2] += bflo(v.y); a[3] += bfhi(v.y);
        a[4] += bflo(v.z); a[5] += bfhi(v.z); a[6] += bflo(v.w); a[7] += bfhi(v.w);
      }
#pragma unroll
      for (int q = 0; q < 8; ++q) lds[kr * 64 + d8 * 8 + q] = a[q];
      __syncthreads();
      if (tid < 64) {
        float s = 0.f;
        for (int q = 0; q < 32; ++q) s += lds[q * 64 + tid];
        ((float*)(p.ws + OFF_KMEAN))[(size_t)it * 64 + tid] = s * (1.f / 256.f);
      }
    }
  }
}

DI float wmax(float x) {
  x = fmaxf(x, dppf0<0x128>(x)); x = fmaxf(x, dppf0<0x124>(x)); x = fmaxf(x, dppf0<0x122>(x)); x = fmaxf(x, dppf0<0x121>(x));
  const float s0 = __builtin_bit_cast(float, __builtin_amdgcn_readlane(__builtin_bit_cast(int, x), 0));
  const float s1 = __builtin_bit_cast(float, __builtin_amdgcn_readlane(__builtin_bit_cast(int, x), 16));
  const float s2 = __builtin_bit_cast(float, __builtin_amdgcn_readlane(__builtin_bit_cast(int, x), 32));
  const float s3 = __builtin_bit_cast(float, __builtin_amdgcn_readlane(__builtin_bit_cast(int, x), 48));
  return fmaxf(fmaxf(s0, s1), fmaxf(s2, s3));
}
DI float score_bound(const float* __restrict__ gq, const float* __restrict__ gk, int lane) {
  const float a = wmax(fabsf(gq[lane])), b = wmax(fabsf(gk[lane]));
  return 64.f * a * b * (0.125f * 1.4426950408889634f) * 1.02f + 0.25f;
}

template <int DV, int MODE>
DI void attn_pass(const u16* __restrict__ Qp, const u16* __restrict__ Kp, const u16* __restrict__ VTp, int ldv, int q0, int ntiles,
                  const short* list, unsigned selmask, int own, u16* Ks, u16* Vs, f32x4 (&o)[DV / 16], float& lsum, float M0, int TIDX) {
  const int tid = TIDX, lane = tid & 63, wave = tid >> 6;
  const int r16 = lane & 15, quad = lane >> 4;
  const float SC = 0.125f * 1.4426950408889634f;
  const u16* qrow = Qp + (size_t)(q0 + wave * 16 + r16) * 64;
  bf16x8 qf[2];
  qf[0] = *(const bf16x8*)(qrow + quad * 8);
  qf[1] = *(const bf16x8*)(qrow + 32 + quad * 8);
  float l = 0.f;
#pragma unroll
  for (int mt = 0; mt < DV / 16; ++mt) o[mt] = (f32x4){0.f, 0.f, 0.f, 0.f};
  const int qpos = q0 + wave * 16 + r16;
  const int srow = tid >> 3, sc8 = tid & 7;
  u32x4 rk[2], rv[DV / 32];
  auto key0_of = [&](int ti) -> int {
    if (MODE == 0) return ti == 0 ? q0 : (ti - 1) * 64;
    if (MODE == 1) return (int)list[ti] * 64;
    return ti * 64;
  };
  auto gload = [&](int key0) {
#pragma unroll
    for (int jj = 0; jj < 2; ++jj) rk[jj] = *(const u32x4*)(Kp + (size_t)(key0 + srow + 32 * jj) * 64 + sc8 * 8);
#pragma unroll
    for (int jj = 0; jj < DV / 32; ++jj) rv[jj] = *(const u32x4*)(VTp + (size_t)(srow + 32 * jj) * ldv + key0 + sc8 * 8);
  };
  gload(key0_of(0));
  for (int ti = 0; ti < ntiles; ++ti) {
    const int key0 = key0_of(ti);
    __syncthreads();
#pragma unroll
    for (int jj = 0; jj < 2; ++jj) {
      const int kap = srow + 32 * jj;
      const int rho = (kap & 32) | ((kap & 4) << 2) | ((kap >> 1) & 12) | (kap & 3);
      *(u32x4*)(Ks + rho * LS + sc8 * 8) = rk[jj];
    }
#pragma unroll
    for (int jj = 0; jj < DV / 32; ++jj) *(u32x4*)(Vs + (srow + 32 * jj) * LS + sc8 * 8) = rv[jj];
    __syncthreads();
    if (ti + 1 < ntiles) gload(key0_of(ti + 1));
    bool lanesel = true;
    if (MODE == 1) {
      const int n = key0 >> 8;
      lanesel = (n == own) || ((selmask >> n) & 1u);
      if (__builtin_amdgcn_ballot_w64(lanesel) == 0) continue;
    }
    const bool diag = (MODE != 2) && (key0 == q0);
    f32x4 s[2][2];
#pragma unroll
    for (int g = 0; g < 2; ++g)
#pragma unroll
      for (int u = 0; u < 2; ++u) {
        f32x4 a = {0.f, 0.f, 0.f, 0.f};
        const int krow = 32 * g + 16 * u + r16;
#pragma unroll
        for (int ds = 0; ds < 2; ++ds) {
          bf16x8 kf = *(const bf16x8*)(Ks + krow * LS + ds * 32 + quad * 8);
          a = MFMA16(kf, qf[ds], a);
        }
        s[g][u] = a;
      }
    float rs = 0.f;
#pragma unroll
    for (int g = 0; g < 2; ++g)
#pragma unroll
      for (int u = 0; u < 2; ++u)
#pragma unroll
        for (int i = 0; i < 4; ++i) {
          float v = s[g][u][i] * SC - M0;
          if (diag) {
            int kpos = key0 + 32 * g + 8 * quad + 4 * u + i;
            if (kpos > qpos) v = -1e30f;
          }
          if (MODE == 1) { if (!lanesel) v = -1e30f; }
          const float pv = __builtin_amdgcn_exp2f(v);
          s[g][u][i] = pv;
          rs += pv;
        }
    l += rs;
#pragma unroll
    for (int g = 0; g < 2; ++g) {
      uint4 pw = make_uint4(pk2(s[g][0][0], s[g][0][1]), pk2(s[g][0][2], s[g][0][3]), pk2(s[g][1][0], s[g][1][1]), pk2(s[g][1][2], s[g][1][3]));
      bf16x8 pf = __builtin_bit_cast(bf16x8, pw);
#pragma unroll
      for (int mt = 0; mt < DV / 16; ++mt) {
        bf16x8 vf = *(const bf16x8*)(Vs + (mt * 16 + r16) * LS + g * 32 + quad * 8);
        o[mt] = MFMA16(vf, pf, o[mt]);
      }
    }
  }
  l += __shfl_xor(l, 16);
  l += __shfl_xor(l, 32);
  lsum = l;
}

struct AttnSmem {
  u16 Ks[64 * LS];
  u16 Vs[128 * LS];
  float kmean[32 * 64];
  unsigned sel[64];
  unsigned ormask;
  int ntl;
  short list[128];
};

DI void moba_tile(const P& p, int layer, int item, AttnSmem* sm, int TIDX) {
  const int tid = TIDX, lane = tid & 63, wave = tid >> 6, r16 = lane & 15, quad = lane >> 4;
  const int qt = 127 - item / 12, bh = item % 12;
  const int b = bh / 6, h = bh - b * 6;
  const int q0 = qt * 64, own = q0 >> 8;
  const u16* Q1 = (const u16*)(p.ws + OFF_Q1E) + (size_t)bh * SEQ * 64;
  const u16* K1 = (const u16*)(p.ws + OFF_K1E) + (size_t)bh * SEQ * 64;
  const u16* VT = (const u16*)(p.ws + OFF_VTE) + (size_t)bh * 64 * SEQ;
  const float* kmean = (const float*)(p.ws + OFF_KMEAN) + (size_t)bh * 32 * 64;
  __syncthreads();
  for (int e = tid; e < own * 64; e += 256) sm->kmean[e] = kmean[e];
  if (tid == 0) sm->ormask = 0u;
  __syncthreads();
  {
    const int q = tid >> 2, sub = tid & 3;
    float gate[8];
#pragma unroll
    for (int jn = 0; jn < 8; ++jn) gate[jn] = 0.f;
    const u16* qr = Q1 + (size_t)(q0 + q) * 64;
#pragma unroll
    for (int c = 0; c < 8; ++c) {
      uint4 qv = *(const uint4*)(qr + c * 8);
      float qf[8] = {bflo(qv.x), bfhi(qv.x), bflo(qv.y), bfhi(qv.y), bflo(qv.z), bfhi(qv.z), bflo(qv.w), bfhi(qv.w)};
#pragma unroll
      for (int jn = 0; jn < 8; ++jn) {
        const int n = sub + 4 * jn;
        if (n < own) {
          float4 k0 = *(const float4*)(sm->kmean + n * 64 + c * 8);
          float4 k1 = *(const float4*)(sm->kmean + n * 64 + c * 8 + 4);
          gate[jn] += qf[0] * k0.x + qf[1] * k0.y + qf[2] * k0.z + qf[3] * k0.w + qf[4] * k1.x + qf[5] * k1.y + qf[6] * k1.z + qf[7] * k1.w;
        }
      }
    }
    unsigned selm = 0u;
#pragma unroll
    for (int round = 0; round < 3; ++round) {
      float best = -3e38f;
      int bidx = 999;
#pragma unroll
      for (int jn = 0; jn < 8; ++jn) {
        const int n = sub + 4 * jn;
        if (n < own && !((selm >> n) & 1u) && gate[jn] > best) { best = gate[jn]; bidx = n; }
      }
#pragma unroll
      for (int off = 1; off <= 2; off <<= 1) {
        float ob = __shfl_xor(best, off);
        int oi = __shfl_xor(bidx, off);
        if (ob > best || (ob == best && oi < bidx)) { best = ob; bidx = oi; }
      }
      if (bidx < own) selm |= 1u << bidx;
    }
    if (sub == 0) { sm->sel[q] = selm; atomicOr(&sm->ormask, selm); }
  }
  __syncthreads();
  if (tid == 0) {
    int n = 0;
    sm->list[n++] = (short)(q0 >> 6);
    for (int kt = own * 4; kt < (q0 >> 6); ++kt) sm->list[n++] = (short)kt;
    const unsigned om = sm->ormask;
    for (int blk = 0; blk < own; ++blk)
      if ((om >> blk) & 1u) { for (int q = 0; q < 4; ++q) sm->list[n++] = (short)(blk * 4 + q); }
    sm->ntl = n;
  }
  __syncthreads();
  const unsigned selmask = sm->sel[wave * 16 + r16];
  const int ntiles = sm->ntl;
  f32x4 o[4];
  float l;
  const float M0 = score_bound(p.in[9] + (layer >> 1) * 64, p.in[10] + (layer >> 1) * 64, lane);
  attn_pass<64, 1>(Q1, K1, VT, SEQ, q0, ntiles, sm->list, selmask, own, sm->Ks, sm->Vs, o, l, M0, TIDX);
  const float inv = 1.f / l;
  const int tok = b * SEQ + q0 + wave * 16 + r16;
  const u16* proj = (const u16*)(p.ws + OFF_PROJ);
  u16* mixed = (u16*)(p.ws + OFF_HBUF);
#pragma unroll
  for (int mt = 0; mt < 4; ++mt) {
    const int dv = mt * 16 + quad * 4;
    uint2 gw = *(const uint2*)(proj + (size_t)tok * NP_EVEN + h * 64 + dv);
    float g0 = bflo(gw.x), g1 = bfhi(gw.x), g2 = bflo(gw.y), g3 = bfhi(gw.y);
    *(uint2*)(mixed + (size_t)tok * 1024 + h * 64 + dv) =
        pk4(o[mt][0] * inv * silu(g0), o[mt][1] * inv * silu(g1), o[mt][2] * inv * silu(g2), o[mt][3] * inv * silu(g3));
  }
}

DI void mem_tile(const P& p, int layer, int item, AttnSmem* sm, int TIDX) {
  const int tid = TIDX, lane = tid & 63, wave = tid >> 6, r16 = lane & 15, quad = lane >> 4;
  const int par = layer & 1;
  const int qt = item >> 3, bh = item & 7;
  const int b = bh >> 2, h = bh & 3;
  const int q0 = qt * 64;
  const u16* QM = (const u16*)(p.ws + OFF_QM) + (size_t)bh * SEQ * 64;
  const u16* KM = (const u16*)(p.ws + OFF_KM) + (size_t)bh * 256 * 64;
  const u16* VMT = (const u16*)(p.ws + OFF_VMT) + (size_t)(b * 256 + h * 64) * 256;
  f32x4 o[4];
  float l;
  const float M0 = score_bound(p.in[5] + layer * 64, p.in[6] + layer * 64, lane);
  attn_pass<64, 2>(QM, KM, VMT, 256, q0, 4, nullptr, 0u, 0, sm->Ks, sm->Vs, o, l, M0, TIDX);
  const float inv = 1.f / l;
  const int tok = b * SEQ + q0 + wave * 16 + r16;
  const int NP = par ? NP_ODD : NP_EVEN;
  const int gcol = par ? 1536 : 1984;
  const u16* proj = (const u16*)(p.ws + OFF_PROJ);
  u16* mixed = (u16*)(p.ws + OFF_HBUF);
#pragma unroll
  for (int mt = 0; mt < 4; ++mt) {
    const int dv = mt * 16 + quad * 4;
    uint2 gw = *(const uint2*)(proj + (size_t)tok * NP + gcol + h * 64 + dv);
    float g0 = bflo(gw.x), g1 = bfhi(gw.x), g2 = bflo(gw.y), g3 = bfhi(gw.y);
    *(uint2*)(mixed + (size_t)tok * 1024 + 768 + h * 64 + dv) =
        pk4(o[mt][0] * inv * silu(g0), o[mt][1] * inv * silu(g1), o[mt][2] * inv * silu(g2), o[mt][3] * inv * silu(g3));
  }
}

DI void diff_tile(const P& p, int layer, int item, AttnSmem* sm, int TIDX) {
  const int tid = TIDX, lane = tid & 63, wave = tid >> 6, r16 = lane & 15, quad = lane >> 4;
  const int j = layer >> 1;
  const int qt = 127 - (item >> 3), bh = item & 7;
  const int b = bh >> 2, h = bh & 3;
  const int q0 = qt * 64;
  const u16* VT = (const u16*)(p.ws + OFF_VTO) + (size_t)(b * 512 + h * 128) * SEQ;
  f32x4 o1[8], o[8];
  float l;
  const float M0 = score_bound(p.in[23] + j * 64, p.in[24] + j * 64, lane);
  {
    const u16* Q1 = (const u16*)(p.ws + OFF_Q1O) + (size_t)(b * 8 + h * 2 + 0) * SEQ * 64;
    const u16* K1 = (const u16*)(p.ws + OFF_K1O) + (size_t)(b * 8 + h * 2 + 0) * SEQ * 64;
    attn_pass<128, 0>(Q1, K1, VT, SEQ, q0, qt + 1, nullptr, 0u, 0, sm->Ks, sm->Vs, o1, l, M0, TIDX);
    const float inv = 1.f / l;
#pragma unroll
    for (int mt = 0; mt < 8; ++mt) { o1[mt][0] *= inv; o1[mt][1] *= inv; o1[mt][2] *= inv; o1[mt][3] *= inv; }
  }
  {
    const u16* Q1 = (const u16*)(p.ws + OFF_Q1O) + (size_t)(b * 8 + h * 2 + 1) * SEQ * 64;
    const u16* K1 = (const u16*)(p.ws + OFF_K1O) + (size_t)(b * 8 + h * 2 + 1) * SEQ * 64;
    attn_pass<128, 0>(Q1, K1, VT, SEQ, q0, qt + 1, nullptr, 0u, 0, sm->Ks, sm->Vs, o, l, M0, TIDX);
  }
  int lv = layer;
  asm volatile("" : "+s"(lv));
  const float lam_init = 0.8f - 0.6f * __expf(-0.3f * (float)lv);
  float lam;
  {
    float a = p.in[25][j * 64 + lane] * p.in[26][j * 64 + lane];
    float c = p.in[27][j * 64 + lane] * p.in[28][j * 64 + lane];
    a = wsum(a); c = wsum(c);
    lam = __expf(a) - __expf(c) + lam_init;
  }
  const float inv2 = lam / l;
  float ss = 0.f;
#pragma unroll
  for (int mt = 0; mt < 8; ++mt)
#pragma unroll
    for (int i = 0; i < 4; ++i) { float v = o1[mt][i] - inv2 * o[mt][i]; o1[mt][i] = v; ss += v * v; }
  ss += __shfl_xor(ss, 16);
  ss += __shfl_xor(ss, 32);
  const float rinv = rsqrtf(ss * (1.f / 128.f) + 1e-6f) * (1.f - lam_init);
  const int tok = b * SEQ + q0 + wave * 16 + r16;
  const u16* proj = (const u16*)(p.ws + OFF_PROJ);
  u16* mixed = (u16*)(p.ws + OFF_HBUF);
  const float* sg = p.in[29] + j * 128;
#pragma unroll
  for (int mt = 0; mt < 8; ++mt) {
    const int dv = mt * 16 + quad * 4;
    uint2 gw = *(const uint2*)(proj + (size_t)tok * NP_ODD + h * 128 + dv);
    float g0 = bflo(gw.x), g1 = bfhi(gw.x), g2 = bflo(gw.y), g3 = bfhi(gw.y);
    float4 sgv = *(const float4*)(sg + dv);
    *(uint2*)(mixed + (size_t)tok * 1024 + h * 128 + dv) =
        pk4(o1[mt][0] * rinv * sgv.x * silu(g0), o1[mt][1] * rinv * sgv.y * silu(g1), o1[mt][2] * rinv * sgv.z * silu(g2), o1[mt][3] * rinv * sgv.w * silu(g3));
  }
}

DI void cvt8_store(float* dst, uint4 v) {
  *(float4*)dst = make_float4(bflo(v.x), bfhi(v.x), bflo(v.y), bfhi(v.y));
  *(float4*)(dst + 4) = make_float4(bflo(v.z), bfhi(v.z), bflo(v.w), bfhi(v.w));
}

DI void rwkv_scan(const P& p, int item, char* smem, unsigned* flag, unsigned tag, int TIDX) {
  const int tid = TIDX, lane = tid & 63, wave = tid >> 6;
  const int l16 = lane & 15, rsub = lane >> 4;
  const int bh = item >> 2, qd = item & 3;
  const int b = bh / 6, h = bh - b * 6;
  const int row = qd * 16 + wave * 4 + rsub;
  constexpr int NS = 16;
  constexpr int SLOT = NS * 64;
  constexpr int BUFSZ = 6 * SLOT + 16;
  float* buf = (float*)smem;
  const u16* arrR = (const u16*)(p.ws + OFF_RW_R);
  const u16* arrK = (const u16*)(p.ws + OFF_RW_K);
  const u16* arrV = (const u16*)(p.ws + OFF_RW_V);
  const u16* arrN = (const u16*)(p.ws + OFF_RW_KK);
  const u16* arrB = (const u16*)(p.ws + OFF_RW_BV);
  const float* RW = (const float*)(p.ws + OFF_RW_W);
  const float* RC = (const float*)(p.ws + OFF_RW_C) + (size_t)(b * SEQ + (tid & 15)) * 8 + h;
  u16* yraw = (u16*)(p.ws + OFF_YRAW);
  const int hi = tid >> 7, cidx = tid & 127;
  const int bst = cidx >> 3, bc8 = (cidx & 7) * 8;
  const size_t boff = (size_t)(b * SEQ + bst) * 384 + h * 64 + bc8;
  const u16* s1 = (hi ? arrK : arrR) + boff;
  const u16* s2 = (hi ? arrN : arrV) + boff;
  const int wch3 = cidx, wch4 = 128 + cidx;
  const char* s3 = hi ? (const char*)(RW + (size_t)(b * SEQ + (wch3 >> 4)) * 384 + h * 64 + (wch3 & 15) * 4) : (const char*)(arrB + boff);
  const size_t st3 = hi ? (size_t)NS * 384 * 4 : (size_t)NS * 384 * 2;
  const char* s4 = (const char*)(RW + (size_t)(b * SEQ + (wch4 >> 4)) * 384 + h * 64 + (wch4 & 15) * 4);
  const size_t st4 = (size_t)NS * 384 * 4;
  constexpr int RD = 4;
  u32x4 g1[RD], g2[RD], g3[RD], g4[RD];
  float gc[RD];
#pragma unroll
  for (int k = 0; k < RD; ++k) {
    g1[k] = *(const u32x4*)(s1 + (size_t)k * NS * 384);
    g2[k] = *(const u32x4*)(s2 + (size_t)k * NS * 384);
    g3[k] = *(const u32x4*)(s3 + (size_t)k * st3);
    g4[k] = *(const u32x4*)(s4 + (size_t)k * st4);
    gc[k] = RC[(size_t)k * NS * 8];
  }
  f32x2 Slo = {0.f, 0.f}, Shi = {0.f, 0.f};
  float yv = 0.f, sa = 0.f;
  __builtin_amdgcn_s_setprio(3);
  __syncthreads();
  for (int bt2 = 0; bt2 < SEQ / NS; bt2 += RD) {
#pragma unroll
    for (int k = 0; k < RD; ++k) {
      const int bt = bt2 + k;
      float* cb = buf + (k & 1) * BUFSZ;
      cvt8_store(cb + (hi + 0) * SLOT + bst * 64 + bc8, make_uint4(g1[k][0], g1[k][1], g1[k][2], g1[k][3]));
      cvt8_store(cb + (hi + 2) * SLOT + bst * 64 + bc8, make_uint4(g2[k][0], g2[k][1], g2[k][2], g2[k][3]));
      if (hi) *(u32x4*)(cb + 5 * SLOT + (wch3 >> 4) * 64 + (wch3 & 15) * 4) = g3[k];
      else {
        cvt8_store(cb + 4 * SLOT + bst * 64 + bc8, make_uint4(g3[k][0], g3[k][1], g3[k][2], g3[k][3]));
        *(u32x4*)(cb + 5 * SLOT + (wch4 >> 4) * 64 + (wch4 & 15) * 4) = g4[k];
      }
      if (tid < NS) cb[6 * SLOT + tid] = gc[k];
      __syncthreads();
      if (k == 0 && bt + RD == RWKV_TQ / NS) {
        if (tid == 0) {
          while (__hip_atomic_load(flag, __ATOMIC_RELAXED, __HIP_MEMORY_SCOPE_AGENT) < tag) __builtin_amdgcn_s_sleep(8);
          __builtin_amdgcn_fence(__ATOMIC_ACQUIRE, "agent");
          asm volatile("s_waitcnt vmcnt(0)" ::: "memory");
        }
        __syncthreads();
      }
      {
        const int nb = (bt + RD < SEQ / NS) ? bt + RD : SEQ / NS - 1;
        g1[k] = *(const u32x4*)(s1 + (size_t)nb * NS * 384);
        g2[k] = *(const u32x4*)(s2 + (size_t)nb * NS * 384);
        g3[k] = *(const u32x4*)(s3 + (size_t)nb * st3);
        g4[k] = *(const u32x4*)(s4 + (size_t)nb * st4);
        gc[k] = RC[(size_t)nb * NS * 8];
      }
      constexpr int PD = 2;
      f32x4 qr[PD], qk[PD], qn[PD], qb[PD], qw[PD];
      float qv[PD], qc[PD];
#pragma unroll
      for (int d = 0; d < PD; ++d) {
        qr[d] = *(const f32x4*)(cb + 0 * SLOT + d * 64 + l16 * 4);
        qk[d] = *(const f32x4*)(cb + 1 * SLOT + d * 64 + l16 * 4);
        qv[d] = cb[2 * SLOT + d * 64 + row];
        qn[d] = *(const f32x4*)(cb + 3 * SLOT + d * 64 + l16 * 4);
        qb[d] = *(const f32x4*)(cb + 4 * SLOT + d * 64 + l16 * 4);
        qw[d] = *(const f32x4*)(cb + 5 * SLOT + d * 64 + l16 * 4);
        qc[d] = cb[6 * SLOT + d];
      }
#pragma unroll
      for (int s = 0; s < NS; ++s) {
        const f32x4 r4 = qr[s % PD], k4 = qk[s % PD], n4 = qn[s % PD], b4 = qb[s % PD], w4 = qw[s % PD];
        const float vv = qv[s % PD], cc = qc[s % PD];
        if (s + PD < NS) {
          qr[s % PD] = *(const f32x4*)(cb + 0 * SLOT + (s + PD) * 64 + l16 * 4);
          qk[s % PD] = *(const f32x4*)(cb + 1 * SLOT + (s + PD) * 64 + l16 * 4);
          qv[s % PD] = cb[2 * SLOT + (s + PD) * 64 + row];
          qn[s % PD] = *(const f32x4*)(cb + 3 * SLOT + (s + PD) * 64 + l16 * 4);
          qb[s % PD] = *(const f32x4*)(cb + 4 * SLOT + (s + PD) * 64 + l16 * 4);
          qw[s % PD] = *(const f32x4*)(cb + 5 * SLOT + (s + PD) * 64 + l16 * 4);
          qc[s % PD] = cb[6 * SLOT + s + PD];
        }
        const f32x2 vv2 = {vv, vv};
        const f32x2 sa2 = {sa, sa};
        const f32x2 Tlo = Slo * w4.xy + vv2 * k4.xy;
        const f32x2 Thi = Shi * w4.zw + vv2 * k4.zw;
        Slo = Tlo + sa2 * b4.xy;
        Shi = Thi + sa2 * b4.zw;
        const f32x2 tu = Tlo * n4.xy + Thi * n4.zw;
        const f32x2 ty = Slo * r4.xy + Shi * r4.zw;
        float pu = tu.x + tu.y;
        float py = ty.x + ty.y;
        allred16_2(pu, py);
        sa = -(pu + sa * cc);
        if (l16 == s) yv = py;
        __builtin_amdgcn_sched_barrier(0);
      }
      {
        const int tok = b * SEQ + bt * NS + l16;
        yraw[(size_t)tok * 384 + h * 64 + row] = f2bf(yv);
      }
    }
  }
  __builtin_amdgcn_s_setprio(0);
}

DI void hgrn_scan(const P& p, int layer, int item, char* smem, int TIDX) {
  const int tid = TIDX, lane = tid & 63, wave = tid >> 6;
  const int l16 = lane & 15, rsub = lane >> 4;
  const int bh = item >> 2, qd = item & 3;
  const int b = bh >> 2, h = bh & 3;
  const int col = qd * 16 + wave * 4 + rsub;
  constexpr int NS = 32, SLOT = NS * 64, BUFSZ = 3 * SLOT, RD = 4;
  float* buf = (float*)smem;
  const u16* proj = (const u16*)(p.ws + OFF_PROJ);
  const float* HF = (const float*)(p.ws + OFF_HF);
  u16* mixed = (u16*)(p.ws + OFF_HBUF);
  const int ast = tid >> 3, ac8 = (tid & 7) * 8;
  const u16* sq_ = proj + (size_t)(b * SEQ + ast) * NP_ODD + 512 + h * 64 + ac8;
  const u16* sv_ = proj + (size_t)(b * SEQ + ast) * NP_ODD + 1024 + h * 64 + ac8;
  const int fst = tid >> 4, fc4 = (tid & 15) * 4;
  const float* sf_ = HF + (size_t)(b * SEQ + fst) * 256 + h * 64 + fc4;
  u32x4 gq[RD], gv[RD], gf0[RD], gf1[RD];
#pragma unroll
  for (int k = 0; k < RD; ++k) {
    gq[k] = *(const u32x4*)(sq_ + (size_t)k * NS * NP_ODD);
    gv[k] = *(const u32x4*)(sv_ + (size_t)k * NS * NP_ODD);
    gf0[k] = *(const u32x4*)(sf_ + (size_t)k * NS * 256);
    gf1[k] = *(const u32x4*)(sf_ + (size_t)(k * NS + 16) * 256);
  }
  f32x2 Slo = {0.f, 0.f}, Shi = {0.f, 0.f};
  float yv = 0.f;
  __builtin_amdgcn_s_setprio(3);
  __syncthreads();
  for (int bt4 = 0; bt4 < SEQ / NS; bt4 += RD) {
#pragma unroll
    for (int k = 0; k < RD; ++k) {
      const int bt = bt4 + k;
      float* cb = buf + (k & 1) * BUFSZ;
      cvt8_store(cb + 0 * SLOT + ast * 64 + ac8, make_uint4(gq[k][0], gq[k][1], gq[k][2], gq[k][3]));
      cvt8_store(cb + 1 * SLOT + ast * 64 + ac8, make_uint4(gv[k][0], gv[k][1], gv[k][2], gv[k][3]));
      *(u32x4*)(cb + 2 * SLOT + fst * 64 + fc4) = gf0[k];
      *(u32x4*)(cb + 2 * SLOT + (fst + 16) * 64 + fc4) = gf1[k];
      __syncthreads();
      {
        const int nb = (bt + RD < SEQ / NS) ? bt + RD : SEQ / NS - 1;
        gq[k] = *(const u32x4*)(sq_ + (size_t)nb * NS * NP_ODD);
        gv[k] = *(const u32x4*)(sv_ + (size_t)nb * NS * NP_ODD);
        gf0[k] = *(const u32x4*)(sf_ + (size_t)nb * NS * 256);
        gf1[k] = *(const u32x4*)(sf_ + (size_t)(nb * NS + 16) * 256);
      }
      constexpr int PD = 3;
      f32x4 qq[PD], qf[PD];
      float qv[PD];
#pragma unroll
      for (int d = 0; d < PD; ++d) {
        qq[d] = *(const f32x4*)(cb + 0 * SLOT + d * 64 + l16 * 4);
        qf[d] = *(const f32x4*)(cb + 2 * SLOT + d * 64 + l16 * 4);
        qv[d] = cb[1 * SLOT + d * 64 + col];
      }
#pragma unroll
      for (int oct = 0; oct < NS / 8; ++oct) {
        float pp[8];
#pragma unroll
        for (int s8 = 0; s8 < 8; ++s8) {
          const int s = oct * 8 + s8;
          const f32x4 q4 = qq[s % PD], f4 = qf[s % PD];
          const float vv = qv[s % PD];
          if (s + PD < NS) {
            qq[s % PD] = *(const f32x4*)(cb + 0 * SLOT + (s + PD) * 64 + l16 * 4);
            qf[s % PD] = *(const f32x4*)(cb + 2 * SLOT + (s + PD) * 64 + l16 * 4);
            qv[s % PD] = cb[1 * SLOT + (s + PD) * 64 + col];
          }
          const f32x2 vv2 = {vv, vv};
          Slo = f4.xy * (Slo - vv2) + vv2;
          Shi = f4.zw * (Shi - vv2) + vv2;
          const f32x2 tq = Slo * q4.xy + Shi * q4.zw;
          pp[s8] = tq.x + tq.y;
          __builtin_amdgcn_sched_barrier(0);
        }
#pragma unroll
        for (int s8 = 0; s8 < 8; ++s8) pp[s8] += dppf<0x128>(pp[s8]);
#pragma unroll
        for (int s8 = 0; s8 < 8; ++s8) pp[s8] += dppf<0x124>(pp[s8]);
#pragma unroll
        for (int s8 = 0; s8 < 8; ++s8) pp[s8] += dppf<0x122>(pp[s8]);
#pragma unroll
        for (int s8 = 0; s8 < 8; ++s8) pp[s8] += dppf<0x121>(pp[s8]);
#pragma unroll
        for (int s8 = 0; s8 < 8; ++s8) if (l16 == s8 + 8 * (oct & 1)) yv = pp[s8];
        if (oct & 1) {
          const int tok = b * SEQ + bt * NS + (oct >> 1) * 16 + l16;
          mixed[(size_t)tok * 1024 + 512 + h * 64 + col] = f2bf(yv);
        }
      }
    }
  }
  __builtin_amdgcn_s_setprio(0);
}

DI void phase_mix(const P& p, int layer, char* smem, int ctr_idx, int is_partner, int TIDX) {
  const int tid = TIDX;
  constexpr int NSCAN = 32;
  if ((int)blockIdx.x >= NSCAN && is_partner) return;
  if ((int)blockIdx.x < NSCAN) {
    hgrn_scan(p, layer, (int)blockIdx.x, smem, TIDX);
    asm volatile("" : "+v"(TIDX));
  }
  __shared__ int s_item;
  int* ctr = (int*)(p.ws + OFF_CTR2) + ctr_idx;
  AttnSmem* sm = (AttnSmem*)smem;
  const int n_att = 1024;
  const int n_total = n_att + 1024;
  while (true) {
    __syncthreads();
    if (tid == 0) s_item = atomicAdd(ctr, 1);
    __syncthreads();
    const int item = s_item;
    if (item >= n_total) break;
    asm volatile("" : "+v"(TIDX));
    if (item < n_att) diff_tile(p, layer, item, sm, TIDX);
    else mem_tile(p, layer, item - n_att, sm, TIDX);
  }
}

DI void worker_barrier(unsigned* ctr, unsigned target) {
  asm volatile("s_waitcnt vmcnt(0)" ::: "memory");
  __syncthreads();
  if (threadIdx.x == 0) {
    __builtin_amdgcn_fence(__ATOMIC_RELEASE, "agent");
    asm volatile("s_waitcnt vmcnt(0)" ::: "memory");
    __hip_atomic_fetch_add(ctr, 1u, __ATOMIC_RELAXED, __HIP_MEMORY_SCOPE_AGENT);
    while (__hip_atomic_load(ctr, __ATOMIC_RELAXED, __HIP_MEMORY_SCOPE_AGENT) < target) __builtin_amdgcn_s_sleep(2);
    __builtin_amdgcn_fence(__ATOMIC_ACQUIRE, "agent");
    asm volatile("s_waitcnt vmcnt(0)" ::: "memory");
  }
  __syncthreads();
}

DI void phase_mix_even_split(const P& p, int layer, char* smem, int ctr_idx, int is_partner, int widx, int TIDX) {
  constexpr int NSCAN = 48;
  if ((int)blockIdx.x < NSCAN) {
    rwkv_scan(p, (int)blockIdx.x, smem, (unsigned*)(p.ws + OFF_CTR2) + 44, (unsigned)layer + 1u, TIDX);
    return;
  }
  if (is_partner) return;
  const int nwa = (int)__hip_atomic_load((unsigned*)(p.ws + OFF_CTR2) + 48, __ATOMIC_RELAXED, __HIP_MEMORY_SCOPE_AGENT);
  unsigned* wctr = (unsigned*)(p.ws + OFF_CTR2) + 40;
  const unsigned nw = (unsigned)nwa;
  const unsigned base = (unsigned)(layer >> 1) * 3u;
  phase_prep_even(p, layer, smem, 2, widx, nwa, TIDX);
  worker_barrier(wctr, nw * (base + 1u));
  if (widx == 0 && threadIdx.x == 0) {
    __builtin_amdgcn_fence(__ATOMIC_RELEASE, "agent");
    __hip_atomic_store((unsigned*)(p.ws + OFF_CTR2) + 44, (unsigned)layer + 1u, __ATOMIC_RELAXED, __HIP_MEMORY_SCOPE_AGENT);
  }
  asm volatile("" : "+v"(TIDX));
  phase_gemm_in(p, layer, smem, 2, widx, nwa, TIDX);
  worker_barrier(wctr, nw * (base + 2u));
  asm volatile("" : "+v"(TIDX));
  phase_prep_even(p, layer, smem, 1, widx, nwa, TIDX);
  worker_barrier(wctr, nw * (base + 3u));
  asm volatile("" : "+v"(TIDX));
  __shared__ int s_item2;
  int* ctr = (int*)(p.ws + OFF_CTR2) + ctr_idx;
  AttnSmem* sm = (AttnSmem*)smem;
  const int n_total = 1536 + 1024;
  while (true) {
    __syncthreads();
    if (TIDX == 0) s_item2 = atomicAdd(ctr, 1);
    __syncthreads();
    const int item = s_item2;
    if (item >= n_total) break;
    asm volatile("" : "+v"(TIDX));
    if (item < 1536) moba_tile(p, layer, item, sm, TIDX);
    else mem_tile(p, layer, item - 1536, sm, TIDX);
  }
}

DI void phase_finish(const P& p, int layer, int TIDX) {
  const int tid = TIDX, lane = tid & 63, wave = tid >> 6;
  const int l16 = lane & 15, sub = lane >> 4;
  const int par = layer & 1, j = layer >> 1;
  const u16* proj = (const u16*)(p.ws + OFF_PROJ);
  u16* mixed = (u16*)(p.ws + OFF_HBUF);
  const int nw = gridDim.x * 4;
  if (!par) {
    const u16* RR = (const u16*)(p.ws + OFF_RW_R); const u16* RK = (const u16*)(p.ws + OFF_RW_K); const u16* RV = (const u16*)(p.ws + OFF_RW_V);
    const u16* YR = (const u16*)(p.ws + OFF_YRAW);
    for (int it4 = blockIdx.x * 4 + wave; it4 < NTOK * 6 / 4; it4 += nw) {
      const int it = it4 * 4 + sub;
      const int tok = it / 6, hd = it - tok * 6;
      const int ch = hd * 64 + l16 * 4;
      const size_t o = (size_t)tok * 384 + ch;
      const uint2 yw = *(const uint2*)(YR + o), rw = *(const uint2*)(RR + o), kw = *(const uint2*)(RK + o), vw = *(const uint2*)(RV + o);
      const uint2 gw = *(const uint2*)(proj + (size_t)tok * NP_EVEN + 1600 + ch);
      const float4 lg = *(const float4*)(p.in[19] + j * 384 + ch);
      const float4 lb = *(const float4*)(p.in[20] + j * 384 + ch);
      const float4 rc = *(const float4*)(p.in[18] + j * 384 + ch);
      const float y0 = bflo(yw.x), y1 = bfhi(yw.x), y2 = bflo(yw.y), y3 = bfhi(yw.y);
      const float mean = allred16((y0 + y1) + (y2 + y3)) * (1.f / 64.f);
      const float d0 = y0 - mean, d1 = y1 - mean, d2 = y2 - mean, d3 = y3 - mean;
      const float var = allred16((d0 * d0 + d1 * d1) + (d2 * d2 + d3 * d3)) * (1.f / 64.f);
      const float rs = rsqrtf(var + 64e-5f);
      const float rk = allred16((bflo(rw.x) * bflo(kw.x) * rc.x + bfhi(rw.x) * bfhi(kw.x) * rc.y) +
                                (bflo(rw.y) * bflo(kw.y) * rc.z + bfhi(rw.y) * bfhi(kw.y) * rc.w));
      const float o0 = (d0 * rs * lg.x + lb.x + rk * bflo(vw.x)) * silu(bflo(gw.x));
      const float o1 = (d1 * rs * lg.y + lb.y + rk * bfhi(vw.x)) * silu(bfhi(gw.x));
      const float o2 = (d2 * rs * lg.z + lb.z + rk * bflo(vw.y)) * silu(bflo(gw.y));
      const float o3 = (d3 * rs * lg.w + lb.w + rk * bfhi(vw.y)) * silu(bfhi(gw.y));
      *(uint2*)(mixed + (size_t)tok * 1024 + 384 + ch) = pk4(o0, o1, o2, o3);
    }
  } else {
    const float4 gg = *(const float4*)(p.in[31] + j * 64 + l16 * 4);
    for (int it4 = blockIdx.x * 4 + wave; it4 < NTOK * 4 / 4; it4 += nw) {
      const int it = it4 * 4 + sub;
      const int tok = it >> 2, hd = it & 3;
      const int ch = hd * 64 + l16 * 4;
      u16* mp = mixed + (size_t)tok * 1024 + 512 + ch;
      const uint2 yw = *(const uint2*)mp;
      const uint2 gw = *(const uint2*)(proj + (size_t)tok * NP_ODD + 1280 + ch);
      const float y0 = bflo(yw.x), y1 = bfhi(yw.x), y2 = bflo(yw.y), y3 = bfhi(yw.y);
      const float ms = allred16((y0 * y0 + y1 * y1) + (y2 * y2 + y3 * y3)) * (1.f / 64.f);
      const float rs = rsqrtf(ms + 1e-6f);
      *(uint2*)mp = pk4(y0 * rs * gg.x * silu(bflo(gw.x)), y1 * rs * gg.y * silu(bfhi(gw.x)),
                        y2 * rs * gg.z * silu(bflo(gw.y)), y3 * rs * gg.w * silu(bfhi(gw.y)));
    }
  }
}

#define XB_TMO      128
#define XB_XCNT(j)  (256  + 64 * (j))
#define XB_XSUB(j)  (1280 + 64 * (j))
#define XB_XGEN(j)  (2304 + 64 * (j))
#define XB_TOP      3328
#define XB_TOPGEN   3392
#define XCD_BAR_WORDS 3456
#define XB_SPIN_CAP (1u << 18)
#define LAS __attribute__((address_space(3)))

__device__ __forceinline__ unsigned xb_ld(unsigned* p)              { return __hip_atomic_load(p, __ATOMIC_RELAXED, __HIP_MEMORY_SCOPE_AGENT); }
__device__ __forceinline__ unsigned xb_add(unsigned* p, unsigned v) { return __hip_atomic_fetch_add(p, v, __ATOMIC_RELAXED, __HIP_MEMORY_SCOPE_AGENT); }
__device__ __forceinline__ unsigned xb_xcc_id() { return (unsigned)__builtin_amdgcn_s_getreg((3 << 11) | 20) & 0xFu; }
#define XB_SPIN(cond, bar) do { unsigned _sp = 0; while (cond) { __builtin_amdgcn_s_sleep(1); \
    if ((++_sp & 255u) == 0u) { if (xb_ld(&(bar)[XB_TMO])) break; if (_sp > XB_SPIN_CAP) { atomicAdd(&(bar)[XB_TMO], 1u); break; } } } } while (0)

struct XcdBarrier {
    unsigned* bar; unsigned x;
    volatile LAS unsigned* st;
};

__device__ __forceinline__ XcdBarrier xcd_barrier_post(unsigned* bar, volatile LAS unsigned* st) {
    XcdBarrier b; b.bar = bar; b.x = xb_xcc_id(); b.st = st;
    if (threadIdx.x == 0) (void)xb_add(&bar[XB_XCNT(b.x)], 1u);
    return b;
}
__device__ __forceinline__ void xcd_barrier_complete(unsigned* bar, unsigned x, unsigned& nloc, unsigned& nx) {
    const unsigned G = gridDim.x * gridDim.y * gridDim.z;
    unsigned sum, cnt, mine, sp = 0u;
    for (;;) {
        sum = 0u; cnt = 0u; mine = 0u;
#pragma unroll
        for (unsigned j = 0; j < 16; ++j) { const unsigned c = xb_ld(&bar[XB_XCNT(j)]); sum += c; cnt += (c > 0u) ? 1u : 0u; mine = (j == x) ? c : mine; }
        if (sum == G) break;
        __builtin_amdgcn_s_sleep(1);
        if ((++sp & 255u) == 0u) { if (xb_ld(&bar[XB_TMO])) break; if (sp > XB_SPIN_CAP) { atomicAdd(&bar[XB_TMO], 1u); break; } }
    }
    nloc = mine > 0u ? mine : 1u; nx = cnt > 0u ? cnt : 1u;
}

__device__ __forceinline__ void xcd_barrier(const XcdBarrier& b) {
    asm volatile("s_waitcnt vmcnt(0)" ::: "memory");
    __syncthreads();
    if (threadIdx.x == 0) {
        unsigned* bar = b.bar;
        __builtin_amdgcn_s_waitcnt(0);
        unsigned nloc = b.st[0], nx = b.st[1];
        if (nloc == 0u) { xcd_barrier_complete(bar, b.x, nloc, nx); b.st[0] = nloc; b.st[1] = nx; }
        const unsigned old = xb_add(&bar[XB_XSUB(b.x)], 1u);
        const unsigned gen = old / nloc;
        if (old + 1u == (gen + 1u) * nloc) {
            __builtin_amdgcn_fence(__ATOMIC_RELEASE, "agent");
            asm volatile("s_waitcnt vmcnt(0)" ::: "memory");
            const unsigned og = xb_add(&bar[XB_TOP], 1u);
            const unsigned tg = og / nx;
            if (og + 1u == (tg + 1u) * nx) xb_add(&bar[XB_TOPGEN], 1u);
            else XB_SPIN(xb_ld(&bar[XB_TOPGEN]) == tg, bar);
            __builtin_amdgcn_fence(__ATOMIC_ACQUIRE, "agent");
            xb_add(&bar[XB_XGEN(b.x)], 1u);
            asm volatile("s_waitcnt vmcnt(0)" ::: "memory");
        } else {
            XB_SPIN(xb_ld(&bar[XB_XGEN(b.x)]) == gen, bar);
            __builtin_amdgcn_fence(__ATOMIC_ACQUIRE, "agent");
            asm volatile("s_waitcnt vmcnt(0)" ::: "memory");
        }
    }
    __syncthreads();
}


constexpr int SMEM_BYTES = 2 * 128 * 144 * 2;
constexpr int NPHASE = 24;

template <bool COOP>
__global__ __launch_bounds__(256, 2) void mega(P p, int ph_lo, int ph_hi) {
  __shared__ __attribute__((aligned(16))) char smem[SMEM_BYTES];
  const int wave_s = __builtin_amdgcn_readfirstlane((int)(threadIdx.x >> 6));
  int nsync = 0;
  __shared__ __attribute__((aligned(16))) unsigned xb_st[4];
  __shared__ int s_cls[4];
  if (threadIdx.x < 4) { xb_st[threadIdx.x] = 0u; s_cls[threadIdx.x] = 0; }
  __syncthreads();
  XcdBarrier xb = xcd_barrier_post((unsigned*)(p.ws + OFF_BAR), (volatile LAS unsigned*)xb_st);
  const unsigned cu_key = ((((unsigned)__builtin_amdgcn_s_getreg((3 << 11) | 20) & 0xFu) << 8) |
                           (((unsigned)__builtin_amdgcn_s_getreg((7 << 11) | (8 << 6) | 4)) & 0xFFu)) + 1u;
  if (blockIdx.x < 48 && threadIdx.x == 0)
    __hip_atomic_store((unsigned*)(p.ws + OFF_BAR) + blockIdx.x, cu_key, __ATOMIC_RELAXED, __HIP_MEMORY_SCOPE_AGENT);
  for (int ph = ph_lo; ph < ph_hi; ++ph) {
    const int layer = ph / 6, sub = ph - layer * 6;
    if (sub == 2 && (layer & 1)) continue;
#ifdef ONLY_PHASE
    if (sub != ONLY_PHASE) continue;
#endif
    if (COOP && ph == 1) {
      int t = (int)threadIdx.x;
      asm volatile("" : "+v"(t));
      const unsigned cu_key2 = ((((unsigned)__builtin_amdgcn_s_getreg((3 << 11) | 20) & 0xFu) << 8) |
                                (((unsigned)__builtin_amdgcn_s_getreg((7 << 11) | (8 << 6) | 4)) & 0xFFu)) + 1u;
      if (t < 48) {
        const unsigned k = __hip_atomic_load((unsigned*)(p.ws + OFF_BAR) + t, __ATOMIC_RELAXED, __HIP_MEMORY_SCOPE_AGENT);
        if (k == cu_key2 && t != (int)blockIdx.x) { s_cls[0] = 1; if (t < 32) s_cls[1] = 1; }
      }
      __syncthreads();
      if (t == 0 && blockIdx.x >= 48 && s_cls[0] == 0)
        s_cls[2] = (int)__hip_atomic_fetch_add((unsigned*)(p.ws + OFF_CTR2) + 48, 1u, __ATOMIC_RELAXED, __HIP_MEMORY_SCOPE_AGENT);
      __syncthreads();
    }
    int reps = 1;
    if (sub == PROBE_SUB && (PROBE_PAR == 2 || (layer & 1) == PROBE_PAR)) reps = 2;
    for (int rep = 0; rep < reps; ++rep) {
      if (COOP) { if (rep) { xcd_barrier(xb); ++nsync; } }
      int TIDX = wave_s * 64 + (int)__builtin_amdgcn_mbcnt_hi(~0u, __builtin_amdgcn_mbcnt_lo(~0u, 0u));
      asm volatile("" : "+v"(TIDX));
      int layer_l = layer;
      asm volatile("" : "+s"(layer_l));
      switch (sub) {
        case 0: phase_norm(p, layer_l, smem, TIDX); break;
        case 1: phase_gemm_in(p, layer_l, smem, (layer_l & 1) ? 0 : 1, 0, 0, TIDX); break;
        case 2: phase_prep_even(p, layer_l, smem, 0, 0, 0, TIDX); break;
        case 3:
          if (layer_l & 1) phase_mix(p, layer_l, smem, layer_l + 8 * rep, s_cls[1], TIDX);
          else phase_mix_even_split(p, layer_l, smem, layer_l + 8 * rep, s_cls[0], s_cls[2], TIDX);
          break;
        case 4: phase_finish(p, layer_l, TIDX); break;
        default: phase_gemm_out(p, layer_l, smem, TIDX); break;
      }
    }
    if (COOP) {
      if (ph + 1 < ph_hi) {
        if (ph_lo < 0) cg::this_grid().sync();
        xcd_barrier(xb);
        ++nsync;
      }
    }
  }
}

extern "C" void kernel_launch(void* const* d_in, const int* in_sizes, int n_in, void* d_out, int out_size, void* d_ws, size_t ws_size,
                              hipStream_t stream) {
  P p{};
  for (int i = 0; i < 32; ++i) p.in[i] = (const float*)d_in[i];
  p.out = (float*)d_out;
  p.ws = (char*)d_ws;
  if (ws_size < WS_NEEDED) fprintf(stderr, "workspace too small: %zu < %zu\n", ws_size, (size_t)WS_NEEDED);
  hipMemsetAsync((char*)d_ws + OFF_BAR, 0, 16384 + 256, stream);
#if ONE_LAUNCH
  static int grid_blocks = 0;
  if (!grid_blocks) {
    int dev = 0, cus = 0, per_cu = 0;
    hipGetDevice(&dev);
    hipDeviceGetAttribute(&cus, hipDeviceAttributeMultiprocessorCount, dev);
    hipOccupancyMaxActiveBlocksPerMultiprocessor(&per_cu, mega<true>, 256, 0);
    if (per_cu > 2) per_cu = 2;
    grid_blocks = cus * per_cu;
  }
  int lo = 0, hi = NPHASE;
  void* args[] = {&p, &lo, &hi};
  hipError_t e = hipLaunchCooperativeKernel((void*)mega<true>, dim3(grid_blocks), dim3(256), args, 0, stream);
  if (e != hipSuccess) fprintf(stderr, "cooperative launch failed: %s (grid %d)\n", hipGetErrorString(e), grid_blocks);
#else
  for (int ph = 0; ph < NPHASE; ++ph) {
    if ((ph % 6) == 2 && ((ph / 6) & 1)) continue;
    mega<false><<<512, 256, 0, stream>>>(p, ph, ph + 1);
  }
#endif
}
```
